# Optimizing an MI355X kernel written in HIP

```python
import math
import jax, jax.numpy as jnp
from jax import lax
import numpy as np

D_MODEL = 1024
BATCH = 4
SEQ = 4096
DEPTH = 2
DEC_BATCH = 128
DEC_SEQ = 1
PAST_LEN = 8192
PAGE_SIZE = 128

BRANCH_WIDTH = D_MODEL // 2
N_BRANCH = 3
ML_HEADS = 4
ML_DK = BRANCH_WIDTH // ML_HEADS
ML_DV = BRANCH_WIDTH // ML_HEADS
ML_CHUNK = 128
SWA_HEAD_DIM = 64
SWA_HEADS = BRANCH_WIDTH // SWA_HEAD_DIM
SWA_KV_HEADS = 2
SWA_GROUP = SWA_HEADS // SWA_KV_HEADS
WINDOW = 128
ROT_DIM = SWA_HEAD_DIM // 4
ROPE_THETA = 500000.0
MEM_TOKENS = 256
X_HEADS = 4
X_HEAD_DIM = BRANCH_WIDTH // X_HEADS
D_FF = -(-8 * D_MODEL // (3 * 256)) * 256
LN_EPS = 1e-5
HEAD_NORM_EPS = 1e-6
DEEPNORM_ALPHA = (2 * DEPTH) ** 0.25
DEEPNORM_BETA = (8 * DEPTH) ** -0.25
NEG_INF = -1e30
D_IN = (2 * ML_HEADS * ML_DK + 2 * ML_HEADS * ML_DV + 2 * ML_HEADS
        + SWA_HEADS * SWA_HEAD_DIM + 2 * SWA_KV_HEADS * SWA_HEAD_DIM
        + X_HEADS * X_HEAD_DIM + N_BRANCH * D_MODEL)

kernel_name = "hybrid_mlstm_swa_memory_decoder_step"


def _in_split_points():
    sizes = [ML_HEADS * ML_DK, ML_HEADS * ML_DK, ML_HEADS * ML_DV, ML_HEADS * ML_DV,
             ML_HEADS, ML_HEADS,
             SWA_HEADS * SWA_HEAD_DIM, SWA_KV_HEADS * SWA_HEAD_DIM, SWA_KV_HEADS * SWA_HEAD_DIM,
             X_HEADS * X_HEAD_DIM]
    pts = []
    acc = 0
    for s in sizes:
        acc += s
        pts.append(acc)
    return pts


def layer_norm(x, g, b):
    xf = x.astype(jnp.float32)
    mu = xf.mean(-1, keepdims=True)
    var = jnp.square(xf - mu).mean(-1, keepdims=True)
    return ((xf - mu) * lax.rsqrt(var + LN_EPS) * g.astype(jnp.float32) + b.astype(jnp.float32)).astype(x.dtype)


def partial_rope(x, positions):
    half = ROT_DIM // 2
    inv_freq = ROPE_THETA ** (-jnp.arange(half, dtype=jnp.float32) / half)
    ang = positions.astype(jnp.float32)[:, None] * inv_freq[None, :]
    cos = jnp.cos(ang)[None, :, None, :]
    sin = jnp.sin(ang)[None, :, None, :]
    x1 = x[..., :half].astype(jnp.float32)
    x2 = x[..., half:ROT_DIM].astype(jnp.float32)
    rot = jnp.concatenate([x1 * cos - x2 * sin, x2 * cos + x1 * sin], axis=-1).astype(x.dtype)
    return jnp.concatenate([rot, x[..., ROT_DIM:]], axis=-1)


def mlstm_chunk_step(carry, inp):
    c, n, m = carry
    q, k, v, li, lf = inp
    L = q.shape[2]
    b = jnp.cumsum(lf, axis=-1)
    causal = jnp.tril(jnp.ones((L, L), dtype=bool))
    d = jnp.where(causal, b[..., :, None] - b[..., None, :] + li[..., None, :], -jnp.inf)
    inter = b + m[..., None]
    m_t = jnp.maximum(inter, d.max(-1))
    w = jnp.exp(d - m_t[..., None])
    a = jnp.exp(inter - m_t)
    sw = jnp.einsum('bhtd,bhsd->bhts', q, k) * w
    num = jnp.einsum('bhts,bhsv->bhtv', sw, v) + a[..., None] * jnp.einsum('bhvd,bhtd->bhtv', c, q)
    den = sw.sum(-1) + a * jnp.einsum('bhd,bhtd->bht', n, q)
    h = num / jnp.maximum(jnp.abs(den), jnp.exp(-m_t))[..., None]
    b_last = b[..., -1]
    ws = b_last[..., None] - b + li
    m_new = jnp.maximum(b_last + m, ws.max(-1))
    ec = jnp.exp(b_last + m - m_new)
    es = jnp.exp(ws - m_new[..., None])
    c_new = ec[..., None, None] * c + jnp.einsum('bhs,bhsv,bhsd->bhvd', es, v, k)
    n_new = ec[..., None] * n + jnp.einsum('bhs,bhsd->bhd', es, k)
    return (c_new, n_new, m_new), h


def mlstm(q, k, v, li, lf, c0, n0, m0):
    B, T = q.shape[0], q.shape[1]
    L = min(T, ML_CHUNK)
    nc = T // L

    def chunks(t):
        t = jnp.moveaxis(t, 2, 1)
        t = t.reshape(t.shape[:2] + (nc, L) + t.shape[3:])
        return jnp.moveaxis(t, 2, 0)

    carry0 = (c0.astype(jnp.float32), n0.astype(jnp.float32), m0.astype(jnp.float32))
    xs = (chunks(q), chunks(k), chunks(v), chunks(li), chunks(lf))
    (c, n, m), h = lax.scan(mlstm_chunk_step, carry0, xs)
    h = jnp.moveaxis(h, 0, 2).reshape(B, ML_HEADS, T, ML_DV)
    return jnp.moveaxis(h, 1, 2), c, n, m


def sliding_window_attention(q, k, v, past_k, past_v, pos0, sinks):
    B, T = q.shape[0], q.shape[1]
    L = min(T, WINDOW)
    nb = T // L
    full_k = jnp.concatenate([past_k.astype(k.dtype), k], axis=1)
    full_v = jnp.concatenate([past_v.astype(v.dtype), v], axis=1)
    if nb == 1:
        ctx_k = full_k[:, None]
        ctx_v = full_v[:, None]
    else:
        fk = full_k.reshape(B, nb + 1, WINDOW, SWA_KV_HEADS, SWA_HEAD_DIM)
        fv = full_v.reshape(B, nb + 1, WINDOW, SWA_KV_HEADS, SWA_HEAD_DIM)
        ctx_k = jnp.concatenate([fk[:, :-1], fk[:, 1:]], axis=2)
        ctx_v = jnp.concatenate([fv[:, :-1], fv[:, 1:]], axis=2)
    qb = q.reshape(B, nb, L, SWA_KV_HEADS, SWA_GROUP, SWA_HEAD_DIM)
    starts = pos0 + L * jnp.arange(nb)
    qpos = starts[:, None] + jnp.arange(L)[None, :]
    kpos = starts[:, None] - WINDOW + jnp.arange(WINDOW + L)[None, :]
    kp = kpos[:, None, :]
    qp = qpos[:, :, None]
    allowed = (kp <= qp) & (kp >= qp - WINDOW) & (kp >= 0)
    s = jnp.einsum('bnqkgd,bnskd->bnkgqs', qb, ctx_k).astype(jnp.float32) * (SWA_HEAD_DIM ** -0.5)
    s = jnp.where(allowed[None, :, None, None], s, NEG_INF)
    sink = jnp.broadcast_to(sinks.astype(jnp.float32).reshape(1, 1, SWA_KV_HEADS, SWA_GROUP, 1, 1),
                            s.shape[:-1] + (1,))
    p = jax.nn.softmax(jnp.concatenate([s, sink], axis=-1), axis=-1)[..., :-1]
    o = jnp.einsum('bnkgqs,bnskd->bnqkgd', p.astype(ctx_v.dtype), ctx_v)
    return o.reshape(B, T, SWA_HEADS * SWA_HEAD_DIM), full_k[:, -WINDOW:], full_v[:, -WINDOW:]


def memory_cross_attention(q, mem_k, mem_v):
    s = jnp.einsum('bthd,bmhd->bhtm', q, mem_k.astype(q.dtype)).astype(jnp.float32) * (X_HEAD_DIM ** -0.5)
    p = jax.nn.softmax(s, axis=-1)
    o = jnp.einsum('bhtm,bmhd->bthd', p.astype(q.dtype), mem_v.astype(q.dtype))
    return o.reshape(q.shape[0], q.shape[1], X_HEADS * X_HEAD_DIM)


def trunk_layer(x, pos0, past_k, past_v, c0, n0, m0, mem_k, mem_v,
                w_in, b_gates, mlstm_norm_g, swa_sinks, w_branch, w_mix_out,
                ln1_g, ln1_b, w_ffn_in, w_ffn_out, ln2_g, ln2_b):
    B, T, _ = x.shape
    f32 = jnp.float32
    proj = jnp.einsum('btd,de->bte', x, w_in)
    mq, mk, mv, mo, mi, mf, sq, sk, sv, xq, gl = jnp.split(proj, _in_split_points(), axis=-1)

    q_a = mq.reshape(B, T, ML_HEADS, ML_DK).astype(f32)
    k_a = mk.reshape(B, T, ML_HEADS, ML_DK).astype(f32) * (ML_DK ** -0.5)
    v_a = mv.reshape(B, T, ML_HEADS, ML_DV).astype(f32)
    gate_pre = jnp.concatenate([mi, mf], axis=-1).astype(f32) + b_gates.astype(f32)
    li = gate_pre[..., :ML_HEADS]
    lf = jax.nn.log_sigmoid(gate_pre[..., ML_HEADS:])
    h_a, c_new, n_new, m_new = mlstm(q_a, k_a, v_a, li, lf, c0, n0, m0)
    mu = h_a.mean(-1, keepdims=True)
    var = jnp.square(h_a - mu).mean(-1, keepdims=True)
    h_a = ((h_a - mu) * lax.rsqrt(var + HEAD_NORM_EPS)).reshape(B, T, ML_HEADS * ML_DV) * mlstm_norm_g.astype(f32)
    y_a = (jax.nn.sigmoid(mo.astype(f32)) * h_a).astype(x.dtype)

    positions = pos0 + jnp.arange(T)
    q_b = partial_rope(sq.reshape(B, T, SWA_HEADS, SWA_HEAD_DIM), positions)
    k_b = partial_rope(sk.reshape(B, T, SWA_KV_HEADS, SWA_HEAD_DIM), positions)
    v_b = sv.reshape(B, T, SWA_KV_HEADS, SWA_HEAD_DIM)
    y_b, k_buf, v_buf = sliding_window_attention(q_b, k_b, v_b, past_k, past_v, pos0, swa_sinks)

    y_c = memory_cross_attention(xq.reshape(B, T, X_HEADS, X_HEAD_DIM), mem_k, mem_v)

    branches = jnp.stack([y_a, y_b.astype(x.dtype), y_c], axis=2)
    gates = jax.nn.sigmoid(gl.reshape(B, T, N_BRANCH, D_MODEL))
    widened = jnp.einsum('btrc,rcd->btrd', branches, w_branch)
    mixed = jnp.einsum('btd,de->bte', (gates * widened).sum(axis=2), w_mix_out)
    x = layer_norm(DEEPNORM_ALPHA * x + mixed, ln1_g, ln1_b)

    gu = jnp.einsum('btd,df->btf', x, w_ffn_in)
    g, u = jnp.split(gu, 2, axis=-1)
    ffn = jnp.einsum('btf,fd->btd', jax.nn.silu(g) * u, w_ffn_out)
    x = layer_norm(DEEPNORM_ALPHA * x + ffn, ln2_g, ln2_b)
    return x, k_buf, v_buf, c_new, n_new, m_new


def setup_inputs(seed: int = 0) -> dict:
    key = jax.random.key(seed)
    ks = jax.random.split(key, 24)
    f32 = jnp.float32

    def nrm(k, shape, scale=1.0):
        return scale * jax.random.normal(k, shape, f32)

    b_i = nrm(ks[12], (DEPTH, ML_HEADS), 0.1)
    b_f = 3.0 + 3.0 * jax.random.uniform(ks[13], (DEPTH, ML_HEADS), f32)
    return {
        "x_prompt": nrm(ks[0], (BATCH, SEQ, D_MODEL)),
        "x_sample": nrm(ks[1], (DEC_BATCH, DEC_SEQ, D_MODEL)),
        "mem_prompt": nrm(ks[2], (BATCH, MEM_TOKENS, D_MODEL)),
        "cache_swa_k": nrm(ks[3], (DEPTH, DEC_BATCH, WINDOW, SWA_KV_HEADS, SWA_HEAD_DIM)),
        "cache_swa_v": nrm(ks[4], (DEPTH, DEC_BATCH, WINDOW, SWA_KV_HEADS, SWA_HEAD_DIM)),
        "cache_mem_k": nrm(ks[5], (DEPTH, DEC_BATCH, MEM_TOKENS, X_HEADS, X_HEAD_DIM)),
        "cache_mem_v": nrm(ks[6], (DEPTH, DEC_BATCH, MEM_TOKENS, X_HEADS, X_HEAD_DIM)),
        "state_mlstm_c": nrm(ks[7], (DEPTH, DEC_BATCH, ML_HEADS, ML_DV, ML_DK), 0.1),
        "state_mlstm_n": nrm(ks[8], (DEPTH, DEC_BATCH, ML_HEADS, ML_DK), 0.5),
        "state_mlstm_m": nrm(ks[9], (DEPTH, DEC_BATCH, ML_HEADS)),
        "w_in": nrm(ks[10], (DEPTH, D_MODEL, D_IN), D_MODEL ** -0.5),
        "b_gates": jnp.concatenate([b_i, b_f], axis=-1),
        "mlstm_norm_g": 1.0 + nrm(ks[14], (DEPTH, ML_HEADS * ML_DV), 0.02),
        "swa_sinks": nrm(ks[15], (DEPTH, SWA_HEADS), 0.5),
        "w_mem_kv": nrm(ks[16], (DEPTH, D_MODEL, 2 * X_HEADS * X_HEAD_DIM), D_MODEL ** -0.5),
        "w_branch": nrm(ks[17], (DEPTH, N_BRANCH, BRANCH_WIDTH, D_MODEL), DEEPNORM_BETA * BRANCH_WIDTH ** -0.5),
        "w_mix_out": nrm(ks[18], (DEPTH, D_MODEL, D_MODEL), DEEPNORM_BETA * D_MODEL ** -0.5),
        "ln1_g": 1.0 + nrm(ks[19], (DEPTH, D_MODEL), 0.02),
        "ln1_b": nrm(ks[20], (DEPTH, D_MODEL), 0.02),
        "w_ffn_in": nrm(ks[21], (DEPTH, D_MODEL, 2 * D_FF), D_MODEL ** -0.5),
        "w_ffn_out": nrm(ks[22], (DEPTH, D_FF, D_MODEL), DEEPNORM_BETA * D_FF ** -0.5),
        "ln2_g": 1.0 + nrm(ks[23], (DEPTH, D_MODEL), 0.02),
        "ln2_b": nrm(ks[11], (DEPTH, D_MODEL), 0.02),
    }


def reference(x_prompt, x_sample, mem_prompt, cache_swa_k, cache_swa_v, cache_mem_k, cache_mem_v,
              state_mlstm_c, state_mlstm_n, state_mlstm_m, w_in, b_gates, mlstm_norm_g, swa_sinks,
              w_mem_kv, w_branch, w_mix_out, ln1_g, ln1_b, w_ffn_in, w_ffn_out, ln2_g, ln2_b):
    f32 = jnp.float32
    B = x_prompt.shape[0]
    yp = x_prompt
    ys = x_sample
    swa_k_p, swa_v_p, swa_k_s, swa_v_s = [], [], [], []
    mem_k_p, mem_v_p = [], []
    c_p, n_p, m_p, c_s, n_s, m_s = [], [], [], [], [], []
    for l in range(DEPTH):
        weights = (w_in[l], b_gates[l], mlstm_norm_g[l], swa_sinks[l], w_branch[l], w_mix_out[l],
                   ln1_g[l], ln1_b[l], w_ffn_in[l], w_ffn_out[l], ln2_g[l], ln2_b[l])
        mem_kv = jnp.einsum('bmd,de->bme', mem_prompt, w_mem_kv[l]).reshape(B, MEM_TOKENS, 2, X_HEADS, X_HEAD_DIM)
        mk = mem_kv[:, :, 0]
        mv = mem_kv[:, :, 1]
        zero_kv = jnp.zeros((B, WINDOW, SWA_KV_HEADS, SWA_HEAD_DIM), x_prompt.dtype)
        zero_c = jnp.zeros((B, ML_HEADS, ML_DV, ML_DK), f32)
        zero_n = jnp.zeros((B, ML_HEADS, ML_DK), f32)
        zero_m = jnp.zeros((B, ML_HEADS), f32)
        yp, kb, vb, cn, nn_, mn = trunk_layer(yp, 0, zero_kv, zero_kv, zero_c, zero_n, zero_m, mk, mv, *weights)
        swa_k_p.append(kb); swa_v_p.append(vb)
        mem_k_p.append(mk); mem_v_p.append(mv)
        c_p.append(cn); n_p.append(nn_); m_p.append(mn)
        ys, kb, vb, cn, nn_, mn = trunk_layer(ys, PAST_LEN, cache_swa_k[l], cache_swa_v[l],
                                             state_mlstm_c[l], state_mlstm_n[l], state_mlstm_m[l],
                                             cache_mem_k[l], cache_mem_v[l], *weights)
        swa_k_s.append(kb); swa_v_s.append(vb)
        c_s.append(cn); n_s.append(nn_); m_s.append(mn)
    return (yp, ys,
            jnp.stack(swa_k_p), jnp.stack(swa_v_p), jnp.stack(swa_k_s), jnp.stack(swa_v_s),
            jnp.stack(mem_k_p), jnp.stack(mem_v_p),
            jnp.stack(c_p), jnp.stack(n_p), jnp.stack(m_p),
            jnp.stack(c_s), jnp.stack(n_s), jnp.stack(m_s))
```

```cpp
#include <hip/hip_runtime.h>
#include <cstdio>
#include <cstdint>
#include <cmath>

constexpr int DM = 1024, NB = 4, SEQ = 4096, DEPTH = 2, SB = 128  , PAST = 8192;
constexpr int MP = NB * SEQ;
constexpr int MR = MP + 256;
constexpr int NRT = MR / 256;
constexpr int DIN = 6408, NPROJ = 6656, LDP = 6400;
constexpr int DFF = 2816, MEMT = 256;
constexpr int C_MQ = 0, C_MK = 512, C_MV = 1024, C_MO = 1536, C_SQ = 2048, C_SK = 2560, C_SV = 2688, C_XQ = 2816, C_GL = 3328;
constexpr int LDY = 1536;
constexpr float ALPHA = 1.4142135623730951f;
constexpr float LN_EPS = 1e-5f, HN_EPS = 1e-6f;

constexpr size_t O_YP = 0;
constexpr size_t O_YS = O_YP + (size_t)MP * DM;
constexpr size_t O_SKP = O_YS + (size_t)SB * DM;
constexpr size_t O_SVP = O_SKP + (size_t)DEPTH * NB * 128 * 128;
constexpr size_t O_SKS = O_SVP + (size_t)DEPTH * NB * 128 * 128;
constexpr size_t O_SVS = O_SKS + (size_t)DEPTH * SB * 128 * 128;
constexpr size_t O_MKP = O_SVS + (size_t)DEPTH * SB * 128 * 128;
constexpr size_t O_MVP = O_MKP + (size_t)DEPTH * NB * 256 * 512;
constexpr size_t O_CP = O_MVP + (size_t)DEPTH * NB * 256 * 512;
constexpr size_t O_NP = O_CP + (size_t)DEPTH * NB * 4 * 128 * 128;
constexpr size_t O_MPM = O_NP + (size_t)DEPTH * NB * 4 * 128;
constexpr size_t O_CS = O_MPM + (size_t)DEPTH * NB * 4;
constexpr size_t O_NS = O_CS + (size_t)DEPTH * SB * 4 * 128 * 128;
constexpr size_t O_MS = O_NS + (size_t)DEPTH * SB * 4 * 128;
constexpr size_t O_END = O_MS + (size_t)DEPTH * SB * 4;

constexpr size_t MiB = 1u << 20;
constexpr size_t WS_CTL = 0, CTL_ZERO_BYTES = 1 * MiB;
constexpr size_t WS_ROPE = 1 * MiB;
constexpr size_t WS_XS = 2 * MiB;
constexpr size_t WS_GATES = 3 * MiB;
constexpr size_t WS_MISC = 4 * MiB;
constexpr size_t WS_WB = 8 * MiB;
constexpr size_t E_WIN = (size_t)NPROJ * DM, E_WMEM = (size_t)DM * DM, E_WBR = (size_t)DM * 1536, E_WMIX = (size_t)DM * DM, E_WFFI = (size_t)2 * DFF * DM, E_WFFO = (size_t)DM * DFF;
constexpr size_t W_IN0 = 0, W_MEM0 = W_IN0 + E_WIN, W_MEM1 = W_MEM0 + E_WMEM, W_IN1 = W_MEM1 + E_WMEM;
constexpr size_t W_BR0 = W_IN1 + E_WIN, W_BR1 = W_BR0 + E_WBR, W_MIX0 = W_BR1 + E_WBR, W_MIX1 = W_MIX0 + E_WMIX;
constexpr size_t W_FFI0 = W_MIX1 + E_WMIX, W_FFI1 = W_FFI0 + E_WFFI, W_FFO0 = W_FFI1 + E_WFFI, W_FFO1 = W_FFO0 + E_WFFO, W_END = W_FFO1 + E_WFFO;
static_assert(W_END * 2 <= 74 * MiB, "weights fit");
constexpr size_t WS_ACT1 = 82 * MiB;
constexpr size_t WS_MEMB = WS_ACT1 + (size_t)MR * DM * 2;
static_assert(WS_MEMB + (size_t)1024 * 1024 * 2 <= 117 * MiB, "act1+memb");
constexpr size_t WS_PROJ = 117 * MiB;
static_assert((size_t)MR * LDP * 2 <= 204 * MiB, "proj");
constexpr size_t WS_YBR = 321 * MiB;
constexpr size_t WS_TMP = 370 * MiB;
constexpr size_t WS_XF = 435 * MiB;
constexpr size_t WS_MEMKV = 500 * MiB;
constexpr size_t WS_END = 504 * MiB;

typedef unsigned short bf16_t;
typedef float f32x4 __attribute__((ext_vector_type(4)));
typedef float f32x2 __attribute__((ext_vector_type(2)));
typedef unsigned u32x4 __attribute__((ext_vector_type(4)));
typedef unsigned u32x2 __attribute__((ext_vector_type(2)));
typedef short bf16x8 __attribute__((ext_vector_type(8)));
#define LAS __attribute__((address_space(3)))
#define DI __device__ __forceinline__

DI int opaque_tid() { int t = threadIdx.x; asm volatile("" : "+v"(t)); return t; }
DI float bf2f(bf16_t v) { return __uint_as_float(((unsigned)v) << 16); }
DI unsigned f2bf(float f) { unsigned u = __float_as_uint(f); return (u + 0x7fffu + ((u >> 16) & 1u)) >> 16; }
DI unsigned pk2(float lo, float hi) { return f2bf(lo) | (f2bf(hi) << 16); }
DI float lo_bf(unsigned w) { return __uint_as_float(w << 16); }
DI float hi_bf(unsigned w) { return __uint_as_float(w & 0xffff0000u); }
DI float sigmoidf_(float x) { return 1.0f / (1.0f + __expf(-x)); }
DI float logsigmoidf_(float x) { return fminf(x, 0.f) - log1pf(__expf(-fabsf(x))); }
DI float wave_sum(float v) {
#pragma unroll
    for (int o = 1; o < 64; o <<= 1) v += __shfl_xor(v, o);
    return v;
}
DI float wave_max(float v) {
#pragma unroll
    for (int o = 1; o < 64; o <<= 1) v = fmaxf(v, __shfl_xor(v, o));
    return v;
}

struct Params {
    const float* in[23];
    float* out;
    unsigned char* ws;
    int G;
    int pad;
};
typedef const __attribute__((address_space(4))) Params* CP;

namespace pg8 {
#define PG8_LAS __attribute__((address_space(3)))
constexpr int BM = 256, BK = 64, HALF = 128, HTB = HALF * BK * 2  , STAGE_BYTES = 8 * HTB, NXCD = 8, WGM = 8;

__host__ __device__ __forceinline__ int lds_byte(int r, int c) { const int st = (r >> 4) * 2 + (c >> 5), rr = r & 15, cc = c & 31, ob = rr * 64 + cc * 2; return st * 1024 + (ob ^ (((ob >> 9) & 1) << 5)); }
__host__ __device__ __forceinline__ void stage_rc(int b, int& R, int& C) { const int st = b / 1024, sb = b % 1024, swz = sb ^ (((sb >> 9) & 1) << 5); R = (st >> 1) * 16 + swz / 64; C = (st & 1) * 32 + (swz % 64) / 2; }
__host__ __device__ __forceinline__ int perm32(int rho) { const int n = rho >> 4, i = rho & 15; return 8 * (i >> 2) + 4 * n + (i & 3); }

struct Unit { int pm, pn, ko; };
struct Gemm { const bf16_t* A; const bf16_t* Bt; int lda, ldb, K; };

template <int REP> struct Sched {
    int nM, nN, nwg, G, c, kseg, nextra;
    __device__ __forceinline__ void init(int nM_, int nN_, int G_, int c_, int kseg_, int nextra_) { nM = nM_; nN = nN_; nwg = nM * nN; G = G_; c = c_; kseg = kseg_; nextra = nextra_; }
    __device__ __forceinline__ bool next(int i, Unit& u) const {
        const int ti = i / REP, r = i - ti * REP;
        const long L = (long)ti * G + c;
        if (L < nwg) {
            int wgid = (int)L; { const int q = nwg / NXCD, rr = nwg % NXCD, xcd = wgid % NXCD, off = wgid / NXCD; wgid = (xcd < rr ? xcd * (q + 1) : rr * (q + 1) + (xcd - rr) * q) + off; }
            const int nig = WGM * nN, gid = wgid / nig, fm = gid * WGM, gsz = (nM - fm) < WGM ? (nM - fm) : WGM;
            u.pm = fm + ((wgid % nig) % gsz); u.pn = (wgid % nig) / gsz; u.ko = r * kseg; return true;
        }
        const int e = (int)(L - nwg); if (e >= nextra) return false;
        u.pm = NRT + ((e >> 2) & 3); u.pn = 26 + (e >> 4) * 4 + (e & 3); u.ko = 0; return true;
    }
    __device__ __forceinline__ void a_ready(const Unit&) const {}
    __device__ __forceinline__ void done(const Unit&) const {}
};

__device__ __forceinline__ unsigned cvt_pk_bf16(float lo, float hi) { unsigned r; asm volatile("v_cvt_pk_bf16_f32 %0, %1, %2" : "=v"(r) : "v"(lo), "v"(hi)); return r; }


struct EpiProj {
    static constexpr bool PERM = true, AFTER_DRAIN = false;
    bf16_t* proj; float* gates; const float* rope; float* out; bf16_t* memkv; int layer;
    __device__ __forceinline__ void operator()(const f32x4 (&acc)[2][2][4][2], const Unit& u, int wr, int wc, int fr, int fq) const {
        const int row0 = u.pm * BM + wr * 64 + fr, cit = wc * 32 + 8 * fq;
        if (u.pm < NRT) {
            if (u.pn == 25) {
                if (wc == 0 && fq == 0) {
#pragma unroll
                    for (int ai = 0; ai < 2; ++ai)
#pragma unroll
                        for (int m = 0; m < 4; ++m) { float* gp = gates + (size_t)(row0 + ai * HALF + m * 16) * 8; *(f32x4*)gp = acc[ai][0][m][0]; *(f32x4*)(gp + 4) = acc[ai][0][m][1]; }
                }
                return;
            }
            const bool ropeq = (u.pn == 8 || u.pn == 9), ropek = (u.pn == 10);
#pragma unroll
            for (int ai = 0; ai < 2; ++ai)
#pragma unroll
                for (int m = 0; m < 4; ++m) {
                    const int row = row0 + ai * HALF + m * 16;
#pragma unroll
                    for (int bj = 0; bj < 2; ++bj) {
                        f32x4 v0 = acc[ai][bj][m][0], v1 = acc[ai][bj][m][1];
                        if (ropeq || (ropek && bj == 0)) {
                            f32x4 p0, p1;
#pragma unroll
                            for (int k = 0; k < 4; ++k) { p0[k] = __shfl_xor(v0[k], 16); p1[k] = __shfl_xor(v1[k], 16); }
                            if ((wc & 1) == 0 && fq < 2) {
                                const int pidx = (u.pm < 64) ? (row & (SEQ - 1)) : SEQ;
                                const float* rp = rope + (size_t)pidx * 16;
                                const f32x4 c0 = *(const f32x4*)rp, c1 = *(const f32x4*)(rp + 4), s0 = *(const f32x4*)(rp + 8), s1 = *(const f32x4*)(rp + 12);
                                if (fq == 0) { v0 = v0 * c0 - p0 * s0; v1 = v1 * c1 - p1 * s1; }
                                else         { v0 = v0 * c0 + p0 * s0; v1 = v1 * c1 + p1 * s1; }
                            }
                        }
                        u32x4 w; w.x = cvt_pk_bf16(v0[0], v0[1]); w.y = cvt_pk_bf16(v0[2], v0[3]); w.z = cvt_pk_bf16(v1[0], v1[1]); w.w = cvt_pk_bf16(v1[2], v1[3]);
                        *(u32x4*)(proj + (size_t)row * LDP + u.pn * BM + bj * HALF + cit) = w;
                        if (ropek) {
                            float* dst = nullptr;
                            if (u.pm < 64) { if ((u.pm & 15) == 15 && ai == 1) dst = out + (bj ? O_SVP : O_SKP) + ((size_t)(layer * NB + (u.pm >> 4)) * 128 + ((row & (SEQ - 1)) - (SEQ - 128))) * 128 + cit; }
                            else if (ai == 0) dst = out + (bj ? O_SVS : O_SKS) + ((size_t)(layer * SB + (row - MP)) * 128 + 127) * 128 + cit;
                            if (dst) { *(f32x4*)dst = v0; *(f32x4*)(dst + 4) = v1; }
                        }
                    }
                }
        } else {
            const int b = u.pm - NRT, q = u.pn - 26, lw = q >> 2, ct = q & 3;
#pragma unroll
            for (int ai = 0; ai < 2; ++ai)
#pragma unroll
                for (int m = 0; m < 4; ++m) {
                    const int mt = wr * 64 + fr + ai * HALF + m * 16;
#pragma unroll
                    for (int bj = 0; bj < 2; ++bj) {
                        const f32x4 v0 = acc[ai][bj][m][0], v1 = acc[ai][bj][m][1];
                        const int col = ct * BM + bj * HALF + cit;
                        float* dst = out + (col < 512 ? O_MKP : O_MVP) + ((size_t)(lw * NB + b) * MEMT + mt) * 512 + (col & 511);
                        *(f32x4*)dst = v0; *(f32x4*)(dst + 4) = v1;
                        u32x4 w; w.x = cvt_pk_bf16(v0[0], v0[1]); w.y = cvt_pk_bf16(v0[2], v0[3]); w.z = cvt_pk_bf16(v1[0], v1[1]); w.w = cvt_pk_bf16(v1[2], v1[3]);
                        *(u32x4*)(memkv + ((size_t)lw * 1024 + b * MEMT + mt) * 1024 + col) = w;
                    }
                }
        }
    }
};

struct EpiBranch {
    static constexpr bool PERM = true, AFTER_DRAIN = false;
    const bf16_t* proj; float* tmp; bf16_t* S;
    __device__ __forceinline__ void operator()(const f32x4 (&acc)[2][2][4][2], const Unit& u, int wr, int wc, int fr, int fq) const {
        const int row0 = u.pm * BM + wr * 64 + fr, cit = wc * 32 + 8 * fq, r = u.ko >> 9;
#pragma unroll
        for (int ai = 0; ai < 2; ++ai)
#pragma unroll
            for (int m = 0; m < 4; ++m) {
                const int row = row0 + ai * HALF + m * 16;
#pragma unroll
                for (int bj = 0; bj < 2; ++bj) {
                    const int col = u.pn * BM + bj * HALF + cit;
                    const u32x4 g = *(const u32x4*)(proj + (size_t)row * LDP + C_GL + r * 1024 + col);
                    f32x4 v0 = acc[ai][bj][m][0], v1 = acc[ai][bj][m][1];
                    v0[0] *= sigmoidf_(lo_bf(g.x)); v0[1] *= sigmoidf_(hi_bf(g.x)); v0[2] *= sigmoidf_(lo_bf(g.y)); v0[3] *= sigmoidf_(hi_bf(g.y));
                    v1[0] *= sigmoidf_(lo_bf(g.z)); v1[1] *= sigmoidf_(hi_bf(g.z)); v1[2] *= sigmoidf_(lo_bf(g.w)); v1[3] *= sigmoidf_(hi_bf(g.w));
                    float* tp = tmp + (size_t)row * DM + col;
                    if (r > 0) { v0 += *(const f32x4*)tp; v1 += *(const f32x4*)(tp + 4); }
                    if (r < 2) { *(f32x4*)tp = v0; *(f32x4*)(tp + 4) = v1; }
                    else { u32x4 w; w.x = cvt_pk_bf16(v0[0], v0[1]); w.y = cvt_pk_bf16(v0[2], v0[3]); w.z = cvt_pk_bf16(v1[0], v1[1]); w.w = cvt_pk_bf16(v1[2], v1[3]);
                           *(u32x4*)(S + (size_t)row * DM + col) = w; }
                }
            }
    }
};

struct EpiRes {
    static constexpr bool PERM = false, AFTER_DRAIN = false;
    const float* resP; const float* resS; float* outp;
    __device__ __forceinline__ void operator()(const f32x4 (&acc)[2][2][4][2], const Unit& u, int wr, int wc, int fr, int fq) const {
        const int row0 = u.pm * BM + wr * 64 + fr, col0 = u.pn * BM + wc * 32 + 4 * fq;
#pragma unroll
        for (int ai = 0; ai < 2; ++ai)
#pragma unroll
            for (int m = 0; m < 4; ++m) {
                const int row = row0 + ai * HALF + m * 16;
                const float* rp = (row < MP ? resP + (size_t)row * DM : resS + (size_t)(row - MP) * DM) + col0;
                float* op = outp + (size_t)row * DM + col0;
#pragma unroll
                for (int bj = 0; bj < 2; ++bj)
#pragma unroll
                    for (int n = 0; n < 2; ++n) *(f32x4*)(op + bj * HALF + n * 16) = *(const f32x4*)(rp + bj * HALF + n * 16) * ALPHA + acc[ai][bj][m][n];
            }
    }
};

struct EpiSwiglu {
    static constexpr bool PERM = true, AFTER_DRAIN = false;
    bf16_t* H;
    __device__ __forceinline__ void operator()(const f32x4 (&acc)[2][2][4][2], const Unit& u, int wr, int wc, int fr, int fq) const {
        const int row0 = u.pm * BM + wr * 64 + fr, cit = wc * 32 + 8 * fq;
#pragma unroll
        for (int ai = 0; ai < 2; ++ai)
#pragma unroll
            for (int m = 0; m < 4; ++m) {
                const int row = row0 + ai * HALF + m * 16;
                f32x4 h0, h1;
#pragma unroll
                for (int k = 0; k < 4; ++k) { const float g0 = acc[ai][0][m][0][k], g1 = acc[ai][0][m][1][k];
                    h0[k] = g0 * sigmoidf_(g0) * acc[ai][1][m][0][k]; h1[k] = g1 * sigmoidf_(g1) * acc[ai][1][m][1][k]; }
                u32x4 w; w.x = cvt_pk_bf16(h0[0], h0[1]); w.y = cvt_pk_bf16(h0[2], h0[3]); w.z = cvt_pk_bf16(h1[0], h1[1]); w.w = cvt_pk_bf16(h1[2], h1[3]);
                *(u32x4*)(H + (size_t)row * DFF + u.pn * HALF + cit) = w;
            }
    }
};

template <class Epi, class Sched, bool ALIGN_EPI = false, bool SP2 = false>
__device__ __forceinline__ void gemm_phase(PG8_LAS unsigned char* lds, const Gemm g, const Sched& S, const Epi& E) {
    const int tid = opaque_tid(), wid = __builtin_amdgcn_readfirstlane(tid >> 6), lane = tid & 63, wr = wid >> 2, wc = wid & 3, fr = lane & 15, fq = lane >> 4;
    const int K = g.K, nt = K / BK;
    unsigned voffA[2], voffB[2];
#pragma unroll
    for (int i = 0; i < 2; ++i) { int R, C; stage_rc(tid * 16 + i * 8192, R, C); const int Rb = Epi::PERM ? ((R & ~31) + perm32(R & 31)) : R;
        voffA[i] = (unsigned)(R * g.lda + C) * 2u; voffB[i] = (unsigned)(Rb * g.ldb + C) * 2u; }
    const size_t kstep = (size_t)(BK * 2);
    const size_t hstepA = (size_t)HALF * g.lda * 2, hstepB = (size_t)HALF * g.ldb * 2;
    const size_t tstepA = 2 * hstepA, tstepB = 2 * hstepB;
    const unsigned ldsw = (unsigned)wid * 1024u;
    const int aoff = lds_byte(wr * 64 + fr, fq * 8), boff = lds_byte(wc * 32 + fr, fq * 8);
#define PG8_SA(b, h) (((b) * 2 + (h)) * HTB)
#define PG8_SB(b, h) ((4 + (b) * 2 + (h)) * HTB)
#define PG8_STAGE(bufoff, gbase, voff) do { _Pragma("unroll") for (int _i = 0; _i < 2; ++_i) \
        __builtin_amdgcn_global_load_lds((const unsigned*)((const char*)(gbase) + (voff)[_i]), (PG8_LAS unsigned*)(lds + (bufoff) + ldsw + _i * 8192), 16, 0, 0); } while (0)
#define PG8_LDA(dst, b, h) do { _Pragma("unroll") for (int m = 0; m < 4; ++m) _Pragma("unroll") for (int k = 0; k < 2; ++k) dst[m][k] = *(const PG8_LAS bf16x8*)(lds + PG8_SA(b, h) + aoff + m * 2048 + k * 1024); } while (0)
#define PG8_LDB(dst, b, h) do { _Pragma("unroll") for (int n = 0; n < 2; ++n) _Pragma("unroll") for (int k = 0; k < 2; ++k) dst[n][k] = *(const PG8_LAS bf16x8*)(lds + PG8_SB(b, h) + boff + n * 2048 + k * 1024); } while (0)
#define PG8_MMA(ai, bj, At, Bt) do { __builtin_amdgcn_s_setprio(1); _Pragma("unroll") for (int m = 0; m < 4; ++m) _Pragma("unroll") for (int n = 0; n < 2; ++n) _Pragma("unroll") for (int k = 0; k < 2; ++k) \
        acc[ai][bj][m][n] = __builtin_amdgcn_mfma_f32_16x16x32_bf16(Bt[n][k], At[m][k], acc[ai][bj][m][n], 0, 0, 0); __builtin_amdgcn_s_setprio(0); } while (0)
#define PG8_WAIT_V(n) asm volatile("s_waitcnt vmcnt(" #n ")" ::: "memory")
#define PG8_WAIT_L(n) asm volatile("s_waitcnt lgkmcnt(" #n ")" ::: "memory")
#define PG8_BAR __builtin_amdgcn_s_barrier()
#define PG8_SCHED __builtin_amdgcn_sched_barrier(0)
    Unit cur, nxt; int ui = 0;
    if (!S.next(0, cur)) return;
    f32x4 acc[2][2][4][2];
#pragma unroll
    for (int a = 0; a < 2; ++a)
#pragma unroll
        for (int b = 0; b < 2; ++b)
#pragma unroll
            for (int m = 0; m < 4; ++m)
#pragma unroll
                for (int n = 0; n < 2; ++n) acc[a][b][m][n] = (f32x4){0.f, 0.f, 0.f, 0.f};
    bf16x8 At[4][2], B0[2][2], B1[2][2];
    const char* cA = (const char*)g.A + (size_t)cur.pm * tstepA + (size_t)cur.ko * 2; const char* cB = (const char*)g.Bt + (size_t)cur.pn * tstepB + (size_t)cur.ko * 2;
    S.a_ready(cur);
    if constexpr (SP2) {
        PG8_STAGE(PG8_SB(0, 0), cB, voffB); PG8_STAGE(PG8_SB(0, 1), cB + hstepB, voffB); PG8_STAGE(PG8_SA(0, 0), cA, voffA); PG8_STAGE(PG8_SA(0, 1), cA + hstepA, voffA);
        if (wr == 1) PG8_BAR;
        PG8_WAIT_V(2); PG8_BAR;
        PG8_STAGE(PG8_SB(1, 0), cB + kstep, voffB); PG8_STAGE(PG8_SA(1, 0), cA + kstep, voffA); PG8_STAGE(PG8_SB(1, 1), cB + hstepB + kstep, voffB);
        PG8_WAIT_V(6); PG8_BAR;
    } else {
        PG8_STAGE(PG8_SB(0, 0), cB, voffB); PG8_STAGE(PG8_SA(0, 0), cA, voffA); PG8_STAGE(PG8_SB(0, 1), cB + hstepB, voffB); PG8_STAGE(PG8_SA(0, 1), cA + hstepA, voffA);
        if (wr == 1) PG8_BAR;
        PG8_WAIT_V(4); PG8_BAR;
        PG8_STAGE(PG8_SB(1, 0), cB + kstep, voffB); PG8_STAGE(PG8_SA(1, 0), cA + kstep, voffA); PG8_STAGE(PG8_SB(1, 1), cB + hstepB + kstep, voffB);
        PG8_WAIT_V(6); PG8_BAR;
    }
    for (;;) {
        const bool has_next = S.next(ui + 1, nxt);
        const char* nA = has_next ? (const char*)g.A + (size_t)nxt.pm * tstepA + (size_t)nxt.ko * 2 : cA; const char* nB = has_next ? (const char*)g.Bt + (size_t)nxt.pn * tstepB + (size_t)nxt.ko * 2 : cB;
        for (int t = 0; t < nt; t += 2) {
            const bool last = (t == nt - 2);
            const char* a1 = cA + (size_t)(t + 1) * kstep;
            const char* a2 = last ? nA : cA + (size_t)(t + 2) * kstep; const char* b2 = last ? nB : cB + (size_t)(t + 2) * kstep;
            const char* a3 = a2 + kstep; const char* b3 = b2 + kstep;
            if (last && has_next) S.a_ready(nxt);
            if constexpr (SP2) {
            PG8_LDB(B0, 0, 0); PG8_LDB(B1, 0, 1); PG8_SCHED; PG8_LDA(At, 0, 0); PG8_STAGE(PG8_SA(1, 1), a1 + hstepA, voffA);
            PG8_WAIT_V(8); PG8_WAIT_L(0); PG8_BAR; PG8_MMA(0, 0, At, B0); PG8_MMA(0, 1, At, B1); PG8_BAR; PG8_SCHED;
            PG8_LDA(At, 0, 1); PG8_STAGE(PG8_SB(0, 0), b2, voffB); PG8_STAGE(PG8_SB(0, 1), b2 + hstepB, voffB); PG8_STAGE(PG8_SA(0, 0), a2, voffA);
            PG8_WAIT_V(8); PG8_WAIT_L(0); PG8_BAR; PG8_MMA(1, 0, At, B0); PG8_MMA(1, 1, At, B1); PG8_BAR; PG8_SCHED;
            PG8_LDB(B0, 1, 0); PG8_LDB(B1, 1, 1); PG8_SCHED; PG8_LDA(At, 1, 0); PG8_STAGE(PG8_SA(0, 1), a2 + hstepA, voffA);
            PG8_WAIT_V(8); PG8_WAIT_L(0); PG8_BAR; PG8_MMA(0, 0, At, B0); PG8_MMA(0, 1, At, B1); PG8_BAR; PG8_SCHED;
            PG8_LDA(At, 1, 1); PG8_STAGE(PG8_SB(1, 0), b3, voffB); PG8_STAGE(PG8_SB(1, 1), b3 + hstepB, voffB); PG8_STAGE(PG8_SA(1, 0), a3, voffA);
            PG8_WAIT_V(8); PG8_WAIT_L(0); PG8_BAR; PG8_MMA(1, 0, At, B0); PG8_MMA(1, 1, At, B1); PG8_BAR; PG8_SCHED;
            } else {
            PG8_LDB(B0, 0, 0); PG8_SCHED; PG8_LDA(At, 0, 0); PG8_STAGE(PG8_SA(1, 1), a1 + hstepA, voffA);
            PG8_WAIT_L(8); PG8_BAR; PG8_WAIT_L(0); PG8_MMA(0, 0, At, B0); PG8_BAR; PG8_SCHED;
            PG8_LDB(B1, 0, 1); PG8_STAGE(PG8_SB(0, 0), b2, voffB);
            PG8_BAR; PG8_WAIT_L(0); PG8_MMA(0, 1, At, B1); PG8_BAR;
            PG8_LDA(At, 0, 1); PG8_STAGE(PG8_SA(0, 0), a2, voffA);
            PG8_BAR; PG8_WAIT_L(0); PG8_MMA(1, 0, At, B0); PG8_BAR; PG8_SCHED;
            PG8_STAGE(PG8_SB(0, 1), b2 + hstepB, voffB);
            PG8_WAIT_V(6); PG8_BAR; PG8_MMA(1, 1, At, B1); PG8_BAR;
            PG8_LDB(B0, 1, 0); PG8_SCHED; PG8_LDA(At, 1, 0); PG8_STAGE(PG8_SA(0, 1), a2 + hstepA, voffA);
            PG8_WAIT_L(8); PG8_BAR; PG8_WAIT_L(0); PG8_MMA(0, 0, At, B0); PG8_BAR; PG8_SCHED;
            PG8_LDB(B1, 1, 1); PG8_STAGE(PG8_SB(1, 0), b3, voffB);
            PG8_BAR; PG8_WAIT_L(0); PG8_MMA(0, 1, At, B1); PG8_BAR;
            PG8_LDA(At, 1, 1); PG8_STAGE(PG8_SA(1, 0), a3, voffA);
            PG8_BAR; PG8_WAIT_L(0); PG8_MMA(1, 0, At, B0); PG8_BAR; PG8_SCHED;
            PG8_STAGE(PG8_SB(1, 1), b3 + hstepB, voffB);
            PG8_WAIT_V(6); PG8_BAR; PG8_MMA(1, 1, At, B1); PG8_BAR;
            }
        }
        if constexpr (ALIGN_EPI) { if (wr == 0) PG8_BAR; }
        if constexpr (!Epi::AFTER_DRAIN) { E(acc, cur, wr, wc, fr, fq); S.done(cur); }
        if (!has_next) break;
#pragma unroll
        for (int a = 0; a < 2; ++a)
#pragma unroll
            for (int b = 0; b < 2; ++b)
#pragma unroll
                for (int m = 0; m < 4; ++m)
#pragma unroll
                    for (int n = 0; n < 2; ++n) acc[a][b][m][n] = (f32x4){0.f, 0.f, 0.f, 0.f};
        cur = nxt; cA = nA; cB = nB; ++ui;
        if constexpr (ALIGN_EPI) { if (wr == 1) PG8_BAR; }
    }
    PG8_WAIT_V(0);
    if constexpr (!ALIGN_EPI) { if (wr == 0) PG8_BAR; }
    PG8_BAR;
    if constexpr (Epi::AFTER_DRAIN) { E.fused(acc, cur, wr, wc, fr, fq, lds, wid, lane); S.done(cur); }
#undef PG8_SA
#undef PG8_SB
#undef PG8_STAGE
#undef PG8_LDA
#undef PG8_LDB
#undef PG8_MMA
#undef PG8_WAIT_V
#undef PG8_WAIT_L
#undef PG8_BAR
#undef PG8_SCHED
}
}


#define XB_TMO      128
#define XB_XCNT(j)  (256  + 64 * (j))
#define XB_XSUB(j)  (1280 + 64 * (j))
#define XB_XGEN(j)  (2304 + 64 * (j))
#define XB_TOP      3328
#define XB_TOPGEN   3392
#define XCD_BAR_WORDS 3456
#define XB_SPIN_CAP (1u << 22)
DI unsigned xb_ld(unsigned* p)              { return __hip_atomic_load(p, __ATOMIC_RELAXED, __HIP_MEMORY_SCOPE_AGENT); }
DI unsigned xb_add(unsigned* p, unsigned v) { return __hip_atomic_fetch_add(p, v, __ATOMIC_RELAXED, __HIP_MEMORY_SCOPE_AGENT); }
DI unsigned xb_xcc_id() { return (unsigned)__builtin_amdgcn_s_getreg((3 << 11) | 20) & 0xFu; }
#define XB_SPIN(cond, bar) do { unsigned _sp = 0; while (cond) { __builtin_amdgcn_s_sleep(1); \
    if ((++_sp & 255u) == 0u) { if (xb_ld(&(bar)[XB_TMO])) break; if (_sp > XB_SPIN_CAP) { atomicAdd(&(bar)[XB_TMO], 1u); break; } } } } while (0)
struct XcdBarrier { unsigned* bar; unsigned x; volatile LAS unsigned* st; };
DI XcdBarrier xcd_barrier_post(unsigned* bar, volatile LAS unsigned* st) {
    XcdBarrier b; b.bar = bar; b.x = xb_xcc_id(); b.st = st;
    if (threadIdx.x == 0) (void)xb_add(&bar[XB_XCNT(b.x)], 1u);
    return b;
}
DI void xcd_barrier_complete(unsigned* bar, unsigned x, unsigned& nloc, unsigned& nx) {
    const unsigned G = gridDim.x * gridDim.y * gridDim.z;
    unsigned sum, cnt, mine, sp = 0u;
    for (;;) {
        sum = 0u; cnt = 0u; mine = 0u;
#pragma unroll
        for (unsigned j = 0; j < 16; ++j) { const unsigned c = xb_ld(&bar[XB_XCNT(j)]); sum += c; cnt += (c > 0u) ? 1u : 0u; mine = (j == x) ? c : mine; }
        if (sum == G) break;
        __builtin_amdgcn_s_sleep(1);
        if ((++sp & 255u) == 0u) { if (xb_ld(&bar[XB_TMO])) break; if (sp > XB_SPIN_CAP) { atomicAdd(&bar[XB_TMO], 1u); break; } }
    }
    nloc = mine > 0u ? mine : 1u; nx = cnt > 0u ? cnt : 1u;
}
DI void xcd_barrier(const XcdBarrier& b) {
    asm volatile("s_waitcnt vmcnt(0)" ::: "memory");
    __syncthreads();
    if (threadIdx.x == 0) {
        unsigned* bar = b.bar;
        __builtin_amdgcn_s_waitcnt(0);
        unsigned nloc = b.st[0], nx = b.st[1];
        if (nloc == 0u) { xcd_barrier_complete(bar, b.x, nloc, nx); b.st[0] = nloc; b.st[1] = nx; }
        const unsigned old = xb_add(&bar[XB_XSUB(b.x)], 1u);
        const unsigned gen = old / nloc;
        if (old + 1u == (gen + 1u) * nloc) {
            __builtin_amdgcn_fence(__ATOMIC_RELEASE, "agent");
            asm volatile("s_waitcnt vmcnt(0)" ::: "memory");
            const unsigned og = xb_add(&bar[XB_TOP], 1u);
            const unsigned tg = og / nx;
            if (og + 1u == (tg + 1u) * nx) xb_add(&bar[XB_TOPGEN], 1u);
            else XB_SPIN(xb_ld(&bar[XB_TOPGEN]) == tg, bar);
            __builtin_amdgcn_fence(__ATOMIC_ACQUIRE, "agent");
            xb_add(&bar[XB_XGEN(b.x)], 1u);
            asm volatile("s_waitcnt vmcnt(0)" ::: "memory");
        } else {
            XB_SPIN(xb_ld(&bar[XB_XGEN(b.x)]) == gen, bar);
            __builtin_amdgcn_fence(__ATOMIC_ACQUIRE, "agent");
            asm volatile("s_waitcnt vmcnt(0)" ::: "memory");
        }
    }
    __syncthreads();
}

constexpr int NWAVES = 8, NTHR = 512;
constexpr int LDS_BYTES = 163840;
constexpr int LDS_CTL_OFF = 163840 - 256;
#define LDS_WAIT() asm volatile("s_waitcnt lgkmcnt(0)" ::: "memory")

struct Ptrs {
    float* out; float* rope; float* xs; float* gates; float* misc;
    bf16_t* wb; bf16_t* act1; bf16_t* memb; bf16_t* proj; bf16_t* hbuf; bf16_t* ybr; float* tmp; float* xf; bf16_t* memkv;
};
DI Ptrs make_ptrs(CP p) {
    Ptrs q; unsigned char* ws = p->ws;
    q.out = p->out; q.rope = (float*)(ws + WS_ROPE); q.xs = (float*)(ws + WS_XS); q.gates = (float*)(ws + WS_GATES); q.misc = (float*)(ws + WS_MISC);
    q.wb = (bf16_t*)(ws + WS_WB); q.act1 = (bf16_t*)(ws + WS_ACT1); q.memb = (bf16_t*)(ws + WS_MEMB); q.proj = (bf16_t*)(ws + WS_PROJ); q.hbuf = (bf16_t*)(ws + WS_PROJ);
    q.ybr = (bf16_t*)(ws + WS_YBR); q.tmp = (float*)(ws + WS_TMP); q.xf = (float*)(ws + WS_XF); q.memkv = (bf16_t*)(ws + WS_MEMKV);
    return q;
}

DI int win_src(int n) { return n < 2048 ? n : (n < 6400 ? n + 8 : (n < 6408 ? 2048 + (n - 6400) : -1)); }
DI int ffi_src(int n) { const int T = n >> 8, j = n & 255; return j < 128 ? T * 128 + j : DFF + T * 128 + (j - 128); }

template <int MODE> DI void p0_transpose_item(const float* W, int Nsrc, bf16_t* WT, int ldd, int dcol0, int Ndest, LAS float* scr, int item, int lane) {
    const int nblk = Ndest / 32, kb = item / nblk, nb = item % nblk, k0 = 64 * kb, n0 = 32 * nb;
    const int n = n0 + (lane & 31);
    const int sc = MODE == 1 ? win_src(n) : (MODE == 2 ? ffi_src(n) : n);
    const float scale = (MODE == 1 && n >= 512 && n < 1024) ? 0.08838834764831845f : 1.0f;
#pragma unroll 8
    for (int i = 0; i < 32; ++i) { const int kk = 2 * i + (lane >> 5); scr[kk * 33 + (lane & 31)] = sc >= 0 ? W[(size_t)(k0 + kk) * Nsrc + sc] * scale : 0.f; }
    LDS_WAIT(); asm volatile("" ::: "memory");
    const int c = lane & 7;
#pragma unroll
    for (int j = 0; j < 4; ++j) { const int nn = (lane >> 3) + 8 * j; const LAS float* s = scr + (8 * c) * 33 + nn;
        u32x4 o; o.x = pk2(s[0 * 33], s[1 * 33]); o.y = pk2(s[2 * 33], s[3 * 33]); o.z = pk2(s[4 * 33], s[5 * 33]); o.w = pk2(s[6 * 33], s[7 * 33]);
        *(u32x4*)(WT + (size_t)(n0 + nn) * ldd + dcol0 + k0 + 8 * c) = o; }
    LDS_WAIT(); asm volatile("" ::: "memory");
}

DI void sincos_taylor(double r, double& c, double& s) {
    const double r2 = r * r; double tc = 1.0, ts = r; c = 1.0; s = r;
#pragma unroll
    for (int k = 1; k <= 15; ++k) { tc *= -r2 / (double)((2 * k - 1) * (2 * k)); ts *= -r2 / (double)((2 * k) * (2 * k + 1)); c += tc; s += ts; }
}

DI void phase_prologue(CP p, const Ptrs& q, LAS unsigned char* lds) {
    const int tid = opaque_tid(), lane = tid & 63, wave = tid >> 6;
    const int gw = blockIdx.x * NWAVES + wave, NGW = p->G * NWAVES;
    LAS float* scr = (LAS float*)(lds + wave * 16384);
    constexpr int I_IN = 16 * (NPROJ / 32), I_MEM = 16 * 32, I_BR = 8 * 32, I_MIX = 16 * 32, I_FFI = 16 * (2 * DFF / 32), I_FFO = (DFF / 64) * 32;
    constexpr int PER_L = I_IN + I_MEM + 3 * I_BR + I_MIX + I_FFI + I_FFO;
    for (int it = gw; it < 2 * PER_L; it += NGW) {
        const int l = it / PER_L; int r = it - l * PER_L;
        if (r < I_IN) { p0_transpose_item<1>(p->in[10] + (size_t)l * DM * DIN, DIN, q.wb + (l ? W_IN1 : W_IN0), DM, 0, NPROJ, scr, r, lane); continue; } r -= I_IN;
        if (r < I_MEM) { p0_transpose_item<0>(p->in[14] + (size_t)l * DM * DM, DM, q.wb + (l ? W_MEM1 : W_MEM0), DM, 0, DM, scr, r, lane); continue; } r -= I_MEM;
        if (r < 3 * I_BR) { const int br = r / I_BR; p0_transpose_item<0>(p->in[15] + (size_t)(l * 3 + br) * 512 * DM, DM, q.wb + (l ? W_BR1 : W_BR0), 1536, br * 512, DM, scr, r - br * I_BR, lane); continue; } r -= 3 * I_BR;
        if (r < I_MIX) { p0_transpose_item<0>(p->in[16] + (size_t)l * DM * DM, DM, q.wb + (l ? W_MIX1 : W_MIX0), DM, 0, DM, scr, r, lane); continue; } r -= I_MIX;
        if (r < I_FFI) { p0_transpose_item<2>(p->in[19] + (size_t)l * DM * 2 * DFF, 2 * DFF, q.wb + (l ? W_FFI1 : W_FFI0), DM, 0, 2 * DFF, scr, r, lane); continue; } r -= I_FFI;
        p0_transpose_item<0>(p->in[20] + (size_t)l * DFF * DM, DM, q.wb + (l ? W_FFO1 : W_FFO0), DFF, 0, DM, scr, r, lane);
    }
    for (int m = gw; m < MR + 1024; m += NGW) {
        const float* src = m < MP ? p->in[0] + (size_t)m * DM : (m < MP + SB ? p->in[1] + (size_t)(m - MP) * DM : (m < MR ? nullptr : p->in[2] + (size_t)(m - MR) * DM));
        bf16_t* dst = q.act1 + (size_t)m * DM;
#pragma unroll
        for (int j = 0; j < 4; ++j) {
            const f32x4 v = src ? *(const f32x4*)(src + 4 * lane + 256 * j) : (f32x4){0.f, 0.f, 0.f, 0.f};
            u32x2 w; w.x = pk2(v[0], v[1]); w.y = pk2(v[2], v[3]);
            *(u32x2*)(dst + 4 * lane + 256 * j) = w;
            if (m >= MP && m < MR) *(f32x4*)(q.xs + (size_t)(m - MP) * DM + 4 * lane + 256 * j) = v;
        }
    }
    for (int i = blockIdx.x * NTHR + tid; i < 128 * LDY / 8; i += p->G * NTHR) *(u32x4*)(q.ybr + (size_t)(MP + SB) * LDY + (size_t)i * 8) = (u32x4){0u, 0u, 0u, 0u};
    for (int i = blockIdx.x * NTHR + tid; i < (SEQ + 1) * 8; i += p->G * NTHR) {
        const int pr = i >> 3, f = i & 7; const double pos = pr < SEQ ? (double)pr : (double)PAST;
        const double invf = f == 0 ? 1.0 : f == 1 ? 0.19392274474868576 : f == 2 ? 0.03760603093086393 : f == 3 ? 0.007292664737217109 : f == 4 ? 0.001414213562373095
                          : f == 5 ? 0.0002742481756762073 : f == 6 ? 5.318295896944988e-05 : 1.031338537721246e-05;
        const double ang = pos * invf, k = rint(ang * 0.15915494309189535), r = (ang - k * 6.283185307179586) - k * 2.4492935982947064e-16;
        double c, s; sincos_taylor(r, c, s);
        q.rope[pr * 16 + f] = (float)c; q.rope[pr * 16 + 8 + f] = (float)s;
    }
}

DI void phase_ln(CP p, const float* pre, const float* g, const float* b, float* outP, float* outS, bf16_t* xb) {
    const int tid = opaque_tid(), lane = tid & 63, wave = tid >> 6;
    const int gw = blockIdx.x * NWAVES + wave, NGW = p->G * NWAVES;
    f32x4 gv[4], bv[4];
#pragma unroll
    for (int j = 0; j < 4; ++j) { gv[j] = *(const f32x4*)(g + 4 * lane + 256 * j); bv[j] = *(const f32x4*)(b + 4 * lane + 256 * j); }
    for (int m = gw; m < MP + SB; m += NGW) {
        const float* src = pre + (size_t)m * DM;
        f32x4 v[4]; float s = 0.f;
#pragma unroll
        for (int j = 0; j < 4; ++j) { v[j] = *(const f32x4*)(src + 4 * lane + 256 * j); s += (v[j][0] + v[j][1]) + (v[j][2] + v[j][3]); }
        const float mean = wave_sum(s) * (1.f / DM); float s2 = 0.f;
#pragma unroll
        for (int j = 0; j < 4; ++j) { v[j] = v[j] - mean; s2 += (v[j][0] * v[j][0] + v[j][1] * v[j][1]) + (v[j][2] * v[j][2] + v[j][3] * v[j][3]); }
        const float rstd = 1.0f / sqrtf(wave_sum(s2) * (1.f / DM) + LN_EPS);
        float* dst = m < MP ? outP + (size_t)m * DM : outS + (size_t)(m - MP) * DM;
#pragma unroll
        for (int j = 0; j < 4; ++j) {
            const f32x4 y = v[j] * rstd * gv[j] + bv[j];
            *(f32x4*)(dst + 4 * lane + 256 * j) = y;
            if (xb) { u32x2 w; w.x = pk2(y[0], y[1]); w.y = pk2(y[2], y[3]); *(u32x2*)(xb + (size_t)m * DM + 4 * lane + 256 * j) = w; }
        }
    }
}

DI void mlstm_prompt_naive_unit(CP p, const Ptrs& q, int l, int bh, LAS float* sm) {
    const int tid = opaque_tid(), lane = tid & 63, wid = tid >> 6;
    const int b = bh >> 2, h = bh & 3, v = tid >> 2, part = tid & 3;
    const float bi = p->in[11][l * 8 + h], bfg = p->in[11][l * 8 + 4 + h];
    const float gn = p->in[12][l * 512 + h * 128 + v];
    float C[32], n[32]; float m = 0.f;
#pragma unroll
    for (int j = 0; j < 32; ++j) { C[j] = 0.f; n[j] = 0.f; }
    for (int t = 0; t < SEQ; ++t) {
        const size_t row = (size_t)b * SEQ + t;
        __syncthreads();
        if (tid < 384) { const int which = tid >> 7, d = tid & 127; const int col = (which == 0 ? C_MQ : (which == 1 ? C_MK : C_MV)) + h * 128 + d; sm[tid] = bf2f(q.proj[row * LDP + col]); }
        __syncthreads();
        const float li = q.gates[row * 8 + h] + bi, lf = logsigmoidf_(q.gates[row * 8 + 4 + h] + bfg);
        const float mn = fmaxf(lf + m, li), a = expf(lf + m - mn), w = expf(li - mn);
        const float vv = sm[256 + v] * w;
        float cq = 0.f, nq = 0.f;
#pragma unroll
        for (int j = 0; j < 32; ++j) { const int d = part * 32 + j; const float kd = sm[128 + d], qd = sm[d];
            C[j] = a * C[j] + vv * kd; n[j] = a * n[j] + w * kd; cq += C[j] * qd; nq += n[j] * qd; }
        cq += __shfl_xor(cq, 1); cq += __shfl_xor(cq, 2); nq += __shfl_xor(nq, 1); nq += __shfl_xor(nq, 2);
        const float hval = cq / fmaxf(fabsf(nq), expf(-mn)); m = mn;
        const float s1 = wave_sum(hval) * 0.25f;
        if (lane == 0) sm[384 + wid] = s1;
        __syncthreads();
        float mu = 0.f;
#pragma unroll
        for (int i = 0; i < 8; ++i) mu += sm[384 + i];
        mu *= (1.f / 128.f);
        const float dv = hval - mu; const float s2 = wave_sum(dv * dv) * 0.25f;
        if (lane == 0) sm[392 + wid] = s2;
        __syncthreads();
        float var = 0.f;
#pragma unroll
        for (int i = 0; i < 8; ++i) var += sm[392 + i];
        var *= (1.f / 128.f);
        const float mo = bf2f(q.proj[row * LDP + C_MO + h * 128 + v]);
        const float y = dv * (1.0f / sqrtf(var + HN_EPS)) * gn * sigmoidf_(mo);
        if (part == 0) q.ybr[row * LDY + h * 128 + v] = (bf16_t)f2bf(y);
    }
    float* co = q.out + O_CP + ((size_t)(l * NB + b) * 4 + h) * 16384 + v * 128 + part * 32;
#pragma unroll
    for (int j = 0; j < 32; ++j) co[j] = C[j];
    if (v == 0) { float* no = q.out + O_NP + ((size_t)(l * NB + b) * 4 + h) * 128 + part * 32;
#pragma unroll
        for (int j = 0; j < 32; ++j) no[j] = n[j]; }
    if (tid == 0) q.out[O_MPM + (size_t)(l * NB + b) * 4 + h] = m;
}

DI void swa_prompt_naive_token(CP p, const Ptrs& q, int l, int row, int hd, int lane, LAS float* wsm) {
    const int b = row / SEQ, t = row % SEQ, kvh = hd >> 2;
    wsm[lane] = bf2f(q.proj[(size_t)row * LDP + C_SQ + hd * 64 + lane]);
    LDS_WAIT();
    const float sink = p->in[13][l * 8 + hd];
    float sc[3]; bool ok[3];
#pragma unroll
    for (int i = 0; i < 3; ++i) {
        const int j = lane + 64 * i, s = t - 128 + j; ok[i] = (j <= 128) && (s >= 0); sc[i] = -1e30f;
        if (ok[i]) {
            const bf16_t* kr = q.proj + ((size_t)b * SEQ + s) * LDP + C_SK + kvh * 64; float dot = 0.f;
#pragma unroll
            for (int c = 0; c < 8; ++c) { const u32x4 kk = *(const u32x4*)(kr + 8 * c); const LAS float* qq = wsm + 8 * c;
                dot += qq[0] * lo_bf(kk.x) + qq[1] * hi_bf(kk.x) + qq[2] * lo_bf(kk.y) + qq[3] * hi_bf(kk.y) + qq[4] * lo_bf(kk.z) + qq[5] * hi_bf(kk.z) + qq[6] * lo_bf(kk.w) + qq[7] * hi_bf(kk.w); }
            sc[i] = dot * 0.125f;
        }
    }
    const float mx = fmaxf(wave_max(fmaxf(fmaxf(sc[0], sc[1]), sc[2])), sink);
    float e[3], es = 0.f;
#pragma unroll
    for (int i = 0; i < 3; ++i) { e[i] = ok[i] ? __expf(sc[i] - mx) : 0.f; es += e[i]; }
    const float inv = 1.0f / (wave_sum(es) + __expf(sink - mx));
#pragma unroll
    for (int i = 0; i < 3; ++i) wsm[64 + lane + 64 * i] = e[i] * inv;
    LDS_WAIT();
    float o = 0.f;
    const int j0 = t >= 128 ? 0 : 128 - t;
    for (int j = j0; j <= 128; ++j) { const int s = t - 128 + j; o += wsm[64 + j] * bf2f(q.proj[((size_t)b * SEQ + s) * LDP + C_SV + kvh * 64 + lane]); }
    q.ybr[(size_t)row * LDY + 512 + hd * 64 + lane] = (bf16_t)f2bf(o);
    LDS_WAIT();
}

DI void cross_prompt_naive_token(CP p, const Ptrs& q, int l, int row, int h, int lane, LAS float* wsm) {
    const int b = row / SEQ;
    wsm[lane] = bf2f(q.proj[(size_t)row * LDP + C_XQ + h * 128 + lane]); wsm[64 + lane] = bf2f(q.proj[(size_t)row * LDP + C_XQ + h * 128 + 64 + lane]);
    LDS_WAIT();
    const bf16_t* kv = q.memkv + ((size_t)l * 1024 + b * MEMT) * 1024;
    float sc[4];
#pragma unroll
    for (int i = 0; i < 4; ++i) {
        const bf16_t* kr = kv + (size_t)(lane + 64 * i) * 1024 + h * 128; float dot = 0.f;
#pragma unroll
        for (int c = 0; c < 16; ++c) { const u32x4 kk = *(const u32x4*)(kr + 8 * c); const LAS float* qq = wsm + 8 * c;
            dot += qq[0] * lo_bf(kk.x) + qq[1] * hi_bf(kk.x) + qq[2] * lo_bf(kk.y) + qq[3] * hi_bf(kk.y) + qq[4] * lo_bf(kk.z) + qq[5] * hi_bf(kk.z) + qq[6] * lo_bf(kk.w) + qq[7] * hi_bf(kk.w); }
        sc[i] = dot * 0.08838834764831845f;
    }
    const float mx = wave_max(fmaxf(fmaxf(sc[0], sc[1]), fmaxf(sc[2], sc[3])));
    float e[4], es = 0.f;
#pragma unroll
    for (int i = 0; i < 4; ++i) { e[i] = __expf(sc[i] - mx); es += e[i]; }
    const float inv = 1.0f / wave_sum(es);
#pragma unroll
    for (int i = 0; i < 4; ++i) wsm[128 + lane + 64 * i] = e[i] * inv;
    LDS_WAIT();
    float o0 = 0.f, o1 = 0.f;
    for (int j = 0; j < MEMT; ++j) { const unsigned vv = *(const unsigned*)(kv + (size_t)j * 1024 + 512 + h * 128 + 2 * lane); const float pj = wsm[128 + j]; o0 += pj * lo_bf(vv); o1 += pj * hi_bf(vv); }
    *(unsigned*)(q.ybr + (size_t)row * LDY + 1024 + h * 128 + 2 * lane) = pk2(o0, o1);
    LDS_WAIT();
}

DI void sample_mlstm_unit(CP p, const Ptrs& q, int l, int unit, LAS float* sm) {
    const int tid = opaque_tid(), lane = tid & 63, wid = tid >> 6, b = unit >> 2, h = unit & 3, d4 = lane & 31;
    const size_t row = MP + b;
    __syncthreads();
    if (tid < 128) sm[tid] = bf2f(q.proj[row * LDP + C_MV + h * 128 + tid]);
    const bf16_t* pr = q.proj + row * LDP + h * 128 + 4 * d4;
    const u32x2 qw = *(const u32x2*)(pr + C_MQ), kw = *(const u32x2*)(pr + C_MK);
    const f32x4 q4 = {lo_bf(qw.x), hi_bf(qw.x), lo_bf(qw.y), hi_bf(qw.y)}, k4 = {lo_bf(kw.x), hi_bf(kw.x), lo_bf(kw.y), hi_bf(kw.y)};
    const size_t sidx = (size_t)(l * SB + b) * 4 + h;
    const float m0 = p->in[9][sidx];
    const float li = q.gates[row * 8 + h] + p->in[11][l * 8 + h], lf = logsigmoidf_(q.gates[row * 8 + 4 + h] + p->in[11][l * 8 + 4 + h]);
    const float mn = fmaxf(lf + m0, li), a = expf(lf + m0 - mn), w = expf(li - mn);
    const f32x4 n4 = *(const f32x4*)(p->in[8] + sidx * 128 + 4 * d4);
    const f32x4 nn4 = n4 * a + k4 * w;
    float nq = nn4[0] * q4[0] + nn4[1] * q4[1] + nn4[2] * q4[2] + nn4[3] * q4[3];
#pragma unroll
    for (int o = 1; o < 32; o <<= 1) nq += __shfl_xor(nq, o);
    if (wid == 0 && lane < 32) *(f32x4*)(q.out + O_NS + sidx * 128 + 4 * d4) = nn4;
    if (tid == 0) q.out[O_MS + sidx] = mn;
    const float dn = fmaxf(fabsf(nq), expf(-mn));
    __syncthreads();
    const float* cin = p->in[7] + sidx * 16384; float* cout = q.out + O_CS + sidx * 16384;
    f32x4 c4[8];
#pragma unroll
    for (int i = 0; i < 8; ++i) { const int v = 16 * wid + 2 * i + (lane >> 5); c4[i] = *(const f32x4*)(cin + v * 128 + 4 * d4); }
#pragma unroll
    for (int i = 0; i < 8; ++i) {
        const int v = 16 * wid + 2 * i + (lane >> 5);
        const float wv = w * sm[v];
        const f32x4 cn = c4[i] * a + k4 * wv;
        *(f32x4*)(cout + v * 128 + 4 * d4) = cn;
        float cq = cn[0] * q4[0] + cn[1] * q4[1] + cn[2] * q4[2] + cn[3] * q4[3];
#pragma unroll
        for (int o = 1; o < 32; o <<= 1) cq += __shfl_xor(cq, o);
        if (d4 == 0) sm[128 + v] = cq / dn;
    }
    __syncthreads();
    const float hv = tid < 128 ? sm[128 + tid] : 0.f;
    const float s1 = wave_sum(hv);
    if (lane == 0) sm[256 + wid] = s1;
    __syncthreads();
    const float mu = (sm[256] + sm[257]) * (1.f / 128.f);
    const float dv = tid < 128 ? hv - mu : 0.f;
    const float s2 = wave_sum(dv * dv);
    if (lane == 0) sm[264 + wid] = s2;
    __syncthreads();
    const float var = (sm[264] + sm[265]) * (1.f / 128.f);
    if (tid < 128) {
        const float mo = bf2f(q.proj[row * LDP + C_MO + h * 128 + tid]);
        q.ybr[row * LDY + h * 128 + tid] = (bf16_t)f2bf(dv * (1.0f / sqrtf(var + HN_EPS)) * p->in[12][l * 512 + h * 128 + tid] * sigmoidf_(mo));
    }
}

DI void sample_swa_unit(CP p, const Ptrs& q, int l, int unit, LAS float* sm) {
    const int tid = opaque_tid(), lane = tid & 63, wid = tid >> 6, b = unit >> 1, kvh = unit & 1;
    const size_t row = MP + b;
    LAS float* Kt = sm;
    LAS float* Vt = sm + 129 * 65;
    LAS float* qs = Vt + 129 * 64;
    LAS float* sc = qs + 256;
    __syncthreads();
    const float* ksrc = p->in[3] + ((size_t)(l * SB + b) * 128 * 2 + kvh) * 64;
    const float* vsrc = p->in[4] + ((size_t)(l * SB + b) * 128 * 2 + kvh) * 64;
    float* kdst = q.out + O_SKS + (size_t)(l * SB + b) * 128 * 128 + kvh * 64;
    float* vdst = q.out + O_SVS + (size_t)(l * SB + b) * 128 * 128 + kvh * 64;
#pragma unroll
    for (int it = 0; it < 4; ++it) {
        const int idx = tid + 512 * it, w = idx >> 4, c4 = idx & 15;
        const f32x4 kv = *(const f32x4*)(ksrc + (size_t)w * 128 + 4 * c4), vv = *(const f32x4*)(vsrc + (size_t)w * 128 + 4 * c4);
        Kt[w * 65 + 4 * c4 + 0] = kv[0]; Kt[w * 65 + 4 * c4 + 1] = kv[1]; Kt[w * 65 + 4 * c4 + 2] = kv[2]; Kt[w * 65 + 4 * c4 + 3] = kv[3];
        *(LAS f32x4*)(Vt + w * 64 + 4 * c4) = vv;
        if (w >= 1) { *(f32x4*)(kdst + (size_t)(w - 1) * 128 + 4 * c4) = kv; *(f32x4*)(vdst + (size_t)(w - 1) * 128 + 4 * c4) = vv; }
    }
    if (tid < 64) Kt[128 * 65 + tid] = bf2f(q.proj[row * LDP + C_SK + kvh * 64 + tid]);
    else if (tid < 128) Vt[128 * 64 + tid - 64] = bf2f(q.proj[row * LDP + C_SV + kvh * 64 + tid - 64]);
    else if (tid >= 256) qs[tid - 256] = bf2f(q.proj[row * LDP + C_SQ + (kvh * 4) * 64 + tid - 256]);
    __syncthreads();
    { const int g = tid >> 7, w = tid & 127; float dot = 0.f;
#pragma unroll 16
      for (int d = 0; d < 64; ++d) dot += qs[g * 64 + d] * Kt[w * 65 + d];
      sc[g * 132 + w] = dot * 0.125f;
      if (tid < 4) { float d2 = 0.f; for (int d = 0; d < 64; ++d) d2 += qs[tid * 64 + d] * Kt[128 * 65 + d]; sc[tid * 132 + 128] = d2 * 0.125f; } }
    __syncthreads();
    if (wid < 4) {
        const int g = wid; const float sink = p->in[13][l * 8 + kvh * 4 + g];
        const float s0 = sc[g * 132 + lane], s1 = sc[g * 132 + 64 + lane], s2 = lane == 0 ? sc[g * 132 + 128] : -1e30f;
        const float mx = fmaxf(wave_max(fmaxf(fmaxf(s0, s1), s2)), sink);
        const float e0 = __expf(s0 - mx), e1 = __expf(s1 - mx), e2 = lane == 0 ? __expf(s2 - mx) : 0.f;
        const float inv = 1.0f / (wave_sum(e0 + e1 + e2) + __expf(sink - mx));
        sc[g * 132 + lane] = e0 * inv; sc[g * 132 + 64 + lane] = e1 * inv; if (lane == 0) sc[g * 132 + 128] = e2 * inv;
    }
    __syncthreads();
    if (tid < 256) { const int g = tid >> 6, d = tid & 63; float o = 0.f;
        for (int j = 0; j <= 128; ++j) o += sc[g * 132 + j] * Vt[j * 64 + d];
        q.ybr[row * LDY + 512 + (kvh * 4 + g) * 64 + d] = (bf16_t)f2bf(o); }
}

DI void sample_cross_unit(CP p, const Ptrs& q, int l, int unit, LAS float* sm) {
    const int tid = opaque_tid(), lane = tid & 63, wid = tid >> 6, b = unit >> 2, h = unit & 3, d4 = lane & 31, hs = lane >> 5;
    const size_t row = MP + b;
    const float* kb = p->in[5] + ((size_t)(l * SB + b) * MEMT * 4 + h) * 128;
    const float* vb = p->in[6] + ((size_t)(l * SB + b) * MEMT * 4 + h) * 128;
    const u32x2 qw = *(const u32x2*)(q.proj + row * LDP + C_XQ + h * 128 + 4 * d4);
    const f32x4 q4 = {lo_bf(qw.x), hi_bf(qw.x), lo_bf(qw.y), hi_bf(qw.y)};
    __syncthreads();
    f32x4 k4[16];
#pragma unroll
    for (int i = 0; i < 16; ++i) k4[i] = *(const f32x4*)(kb + (size_t)(32 * wid + 2 * i + hs) * 512 + 4 * d4);
#pragma unroll
    for (int i = 0; i < 16; ++i) {
        float dot = k4[i][0] * q4[0] + k4[i][1] * q4[1] + k4[i][2] * q4[2] + k4[i][3] * q4[3];
#pragma unroll
        for (int o = 1; o < 32; o <<= 1) dot += __shfl_xor(dot, o);
        if (d4 == 0) sm[32 * wid + 2 * i + hs] = dot * 0.08838834764831845f;
    }
#pragma unroll
    for (int i = 0; i < 16; ++i) k4[i] = *(const f32x4*)(vb + (size_t)(32 * wid + 2 * i + hs) * 512 + 4 * d4);
    __syncthreads();
    const float s0 = sm[lane], s1 = sm[64 + lane], s2 = sm[128 + lane], s3 = sm[192 + lane];
    const float mx = wave_max(fmaxf(fmaxf(s0, s1), fmaxf(s2, s3)));
    const float inv = 1.0f / wave_sum(__expf(s0 - mx) + __expf(s1 - mx) + __expf(s2 - mx) + __expf(s3 - mx));
    f32x4 acc = {0.f, 0.f, 0.f, 0.f};
#pragma unroll
    for (int i = 0; i < 16; ++i) { const float pm = __expf(sm[32 * wid + 2 * i + hs] - mx) * inv; acc += k4[i] * pm; }
#pragma unroll
    for (int k = 0; k < 4; ++k) acc[k] += __shfl_xor(acc[k], 32);
    if (lane < 32) *(LAS f32x4*)(sm + 256 + wid * 128 + 4 * d4) = acc;
    __syncthreads();
    if (tid < 128) { float o = 0.f;
#pragma unroll
        for (int w8 = 0; w8 < 8; ++w8) o += sm[256 + w8 * 128 + tid];
        q.ybr[row * LDY + 1024 + h * 128 + tid] = (bf16_t)f2bf(o); }
}

#ifndef MK_N_LAUNCHES
#define MK_N_LAUNCHES 1
#endif
#ifndef PHMASK
#define PHMASK 0x1ff
#endif
constexpr int PH_PER_LAYER = 8, N_PHASES = 1 + DEPTH * PH_PER_LAYER;
struct Args { Params p; int ph_lo, ph_hi; };

__global__ void __launch_bounds__(NTHR, 2) mega(Args args) {
    extern __shared__ __attribute__((aligned(16))) unsigned char lds_raw[];
    LAS unsigned char* lds = (LAS unsigned char*)lds_raw;
    const int tid = threadIdx.x;
    volatile LAS unsigned* lctl = (volatile LAS unsigned*)(lds + LDS_CTL_OFF);
    if (tid < 64) lctl[tid] = 0u;
    __syncthreads();
    typedef const __attribute__((address_space(4))) Args* CA;
    CA ap0 = (CA)__builtin_amdgcn_kernarg_segment_ptr();
    unsigned* ctl = (unsigned*)(ap0->p.ws + WS_CTL);
    XcdBarrier bar; bar.bar = ctl + 4096; bar.x = 0; bar.st = nullptr;
    const bool multi = (ap0->ph_hi - ap0->ph_lo) > 1;
    if (multi) bar = xcd_barrier_post(ctl + 4096, lctl);
    LAS float* sm = (LAS float*)lds;

    const int ph_lo = ap0->ph_lo, ph_hi = ap0->ph_hi;
#define PH_BEGIN(k) if (ph_lo <= (k) && (k) < ph_hi) { CA ap = (CA)__builtin_amdgcn_kernarg_segment_ptr(); asm volatile("" : "+s"(ap)); CP p = &ap->p; const Ptrs q = make_ptrs(p); const int G = p->G; (void)q; (void)G;
#define PH_END(k) if ((k) + 1 < ph_hi) xcd_barrier(bar); }
    PH_BEGIN(0) if (PHMASK & 1) phase_prologue(p, q, lds); PH_END(0)
#define LAYER(l) \
    PH_BEGIN(1 + 8 * l) if (PHMASK & 2) { \
        pg8::Gemm g{q.act1, q.wb + (l ? W_IN1 : W_IN0), DM, DM, DM}; \
        pg8::Sched<1> S; S.init(NRT, NPROJ / 256, G, (int)blockIdx.x, 0, l == 0 ? 32 : 0); \
        pg8::EpiProj E{q.proj, q.gates, q.rope, q.out, q.memkv, l}; \
        pg8::gemm_phase<pg8::EpiProj, pg8::Sched<1>, true, true>(lds, g, S, E); } PH_END(1 + 8 * l) \
    PH_BEGIN(2 + 8 * l) if (PHMASK & 4) { \
        const int t2 = opaque_tid(), lane2 = t2 & 63, wave2 = __builtin_amdgcn_readfirstlane(t2 >> 6); \
        if (blockIdx.x < 16) mlstm_prompt_naive_unit(p, q, l, (int)blockIdx.x, sm); \
        for (int tok = blockIdx.x; tok < MP; tok += G) swa_prompt_naive_token(p, q, l, tok, wave2, lane2, sm + 1024 + wave2 * 512); \
        for (int pr = blockIdx.x; pr < MP / 2; pr += G) cross_prompt_naive_token(p, q, l, 2 * pr + (wave2 >> 2), wave2 & 3, lane2, sm + 1024 + wave2 * 512); \
        for (int u = blockIdx.x; u < SB * 4; u += G) sample_mlstm_unit(p, q, l, u, sm); \
        for (int u = blockIdx.x; u < SB * 2; u += G) sample_swa_unit(p, q, l, u, sm); \
        for (int u = blockIdx.x; u < SB * 4; u += G) sample_cross_unit(p, q, l, u, sm); \
        __syncthreads(); } PH_END(2 + 8 * l) \
    PH_BEGIN(3 + 8 * l) if (PHMASK & 8) { \
        pg8::Gemm g{q.ybr, q.wb + (l ? W_BR1 : W_BR0), LDY, 1536, 512}; \
        pg8::Sched<3> S; S.init(NRT, 4, G, (int)blockIdx.x, 512, 0); \
        pg8::EpiBranch E{q.proj, q.tmp, q.act1}; \
        pg8::gemm_phase<pg8::EpiBranch, pg8::Sched<3>, true, true>(lds, g, S, E); } PH_END(3 + 8 * l) \
    PH_BEGIN(4 + 8 * l) if (PHMASK & 16) { \
        pg8::Gemm g{q.act1, q.wb + (l ? W_MIX1 : W_MIX0), DM, DM, DM}; \
        pg8::Sched<1> S; S.init(NRT, 4, G, (int)blockIdx.x, 0, 0); \
        pg8::EpiRes E{l ? q.xf : p->in[0], l ? q.xf + (size_t)MP * DM : q.xs, q.tmp}; \
        pg8::gemm_phase<pg8::EpiRes, pg8::Sched<1>, true, true>(lds, g, S, E); } PH_END(4 + 8 * l) \
    PH_BEGIN(5 + 8 * l) if (PHMASK & 32) { \
        phase_ln(p, q.tmp, p->in[17] + l * DM, p->in[18] + l * DM, q.xf, q.xf + (size_t)MP * DM, q.act1); } PH_END(5 + 8 * l) \
    PH_BEGIN(6 + 8 * l) if (PHMASK & 64) { \
        pg8::Gemm g{q.act1, q.wb + (l ? W_FFI1 : W_FFI0), DM, DM, DM}; \
        pg8::Sched<1> S; S.init(NRT, 2 * DFF / 256, G, (int)blockIdx.x, 0, 0); \
        pg8::EpiSwiglu E{q.hbuf}; \
        pg8::gemm_phase<pg8::EpiSwiglu, pg8::Sched<1>, true, true>(lds, g, S, E); } PH_END(6 + 8 * l) \
    PH_BEGIN(7 + 8 * l) if (PHMASK & 128) { \
        pg8::Gemm g{q.hbuf, q.wb + (l ? W_FFO1 : W_FFO0), DFF, DFF, DFF}; \
        pg8::Sched<1> S; S.init(NRT, 4, G, (int)blockIdx.x, 0, 0); \
        pg8::EpiRes E{q.xf, q.xf + (size_t)MP * DM, q.tmp}; \
        pg8::gemm_phase<pg8::EpiRes, pg8::Sched<1>, true, true>(lds, g, S, E); } PH_END(7 + 8 * l) \
    PH_BEGIN(8 + 8 * l) if (PHMASK & 256) { \
        if (l == DEPTH - 1) phase_ln(p, q.tmp, p->in[21] + l * DM, p->in[22] + l * DM, q.out + O_YP, q.out + O_YS, nullptr); \
        else phase_ln(p, q.tmp, p->in[21] + l * DM, p->in[22] + l * DM, q.xf, q.xf + (size_t)MP * DM, q.act1); } PH_END(8 + 8 * l)
    LAYER(0)
    LAYER(1)
#undef LAYER
#undef PH_BEGIN
#undef PH_END
}

extern "C" void kernel_launch(void* const* d_in, const int* in_sizes, int n_in, void* d_out, int out_size, void* d_ws, size_t ws_size, hipStream_t stream) {
    static int grid = 0;
    if (grid == 0) {
        if (n_in != 23 || (size_t)out_size != O_END || ws_size < WS_END) {
            fprintf(stderr, "kernel_launch: unexpected shapes: n_in %d out %d (want %zu) ws %zu (need %zu); nothing launched\n", n_in, out_size, (size_t)O_END, ws_size, (size_t)WS_END);
            grid = -1; return;
        }
        int dev = 0, cus = 0;
        if (hipGetDevice(&dev) != hipSuccess || hipDeviceGetAttribute(&cus, hipDeviceAttributeMultiprocessorCount, dev) != hipSuccess) { grid = -1; return; }
        if (hipFuncSetAttribute((const void*)mega, hipFuncAttributeMaxDynamicSharedMemorySize, LDS_BYTES) != hipSuccess) { fprintf(stderr, "kernel_launch: hipFuncSetAttribute failed\n"); grid = -1; return; }
        (void)hipGetLastError();
        grid = cus;
        if (grid != 256) fprintf(stderr, "kernel_launch: note: %d CUs\n", grid);
    }
    if (grid < 0) return;
    (void)hipMemsetAsync((char*)d_ws + WS_CTL, 0, CTL_ZERO_BYTES, stream);
    Args a{};
    for (int i = 0; i < 23; ++i) a.p.in[i] = (const float*)d_in[i];
    a.p.out = (float*)d_out; a.p.ws = (unsigned char*)d_ws; a.p.G = grid; a.p.pad = 0;
#if MK_N_LAUNCHES == 1
    a.ph_lo = 0; a.ph_hi = N_PHASES;
    hipLaunchKernelGGL(mega, dim3(grid), dim3(NTHR), LDS_BYTES, stream, a);
#else
    for (int ph = 0; ph < N_PHASES; ++ph) { a.ph_lo = ph; a.ph_hi = ph + 1; hipLaunchKernelGGL(mega, dim3(grid), dim3(NTHR), LDS_BYTES, stream, a); }
#endif
}
```

```cpp
#include <hip/hip_runtime.h>
#include <cstdio>
#include <cstdint>
#include <cmath>

constexpr int DM = 1024, NB = 4, SEQ = 4096, DEPTH = 2, SB = 128  , PAST = 8192;
constexpr int MP = NB * SEQ;
constexpr int MR = MP + 256;
constexpr int NRT = MR / 256;
constexpr int DIN = 6408, NPROJ = 6656, LDP = 6400;
constexpr int DFF = 2816, MEMT = 256;
constexpr int C_MQ = 0, C_MK = 512, C_MV = 1024, C_MO = 1536, C_SQ = 2048, C_SK = 2560, C_SV = 2688, C_XQ = 2816, C_GL = 3328;
constexpr int LDY = 1536;
constexpr float ALPHA = 1.4142135623730951f;
constexpr float LN_EPS = 1e-5f, HN_EPS = 1e-6f;

constexpr size_t O_YP = 0;
constexpr size_t O_YS = O_YP + (size_t)MP * DM;
constexpr size_t O_SKP = O_YS + (size_t)SB * DM;
constexpr size_t O_SVP = O_SKP + (size_t)DEPTH * NB * 128 * 128;
constexpr size_t O_SKS = O_SVP + (size_t)DEPTH * NB * 128 * 128;
constexpr size_t O_SVS = O_SKS + (size_t)DEPTH * SB * 128 * 128;
constexpr size_t O_MKP = O_SVS + (size_t)DEPTH * SB * 128 * 128;
constexpr size_t O_MVP = O_MKP + (size_t)DEPTH * NB * 256 * 512;
constexpr size_t O_CP = O_MVP + (size_t)DEPTH * NB * 256 * 512;
constexpr size_t O_NP = O_CP + (size_t)DEPTH * NB * 4 * 128 * 128;
constexpr size_t O_MPM = O_NP + (size_t)DEPTH * NB * 4 * 128;
constexpr size_t O_CS = O_MPM + (size_t)DEPTH * NB * 4;
constexpr size_t O_NS = O_CS + (size_t)DEPTH * SB * 4 * 128 * 128;
constexpr size_t O_MS = O_NS + (size_t)DEPTH * SB * 4 * 128;
constexpr size_t O_END = O_MS + (size_t)DEPTH * SB * 4;

constexpr size_t MiB = 1u << 20;
constexpr size_t WS_CTL = 0, CTL_ZERO_BYTES = 1 * MiB;
constexpr size_t WS_ROPE = 1 * MiB;
constexpr size_t WS_XS = 2 * MiB;
constexpr size_t WS_GATES = 3 * MiB;
constexpr size_t WS_MISC = 4 * MiB;
constexpr size_t WS_WB = 8 * MiB;
constexpr size_t E_WIN = (size_t)NPROJ * DM, E_WMEM = (size_t)DM * DM, E_WBR = (size_t)DM * 1536, E_WMIX = (size_t)DM * DM, E_WFFI = (size_t)2 * DFF * DM, E_WFFO = (size_t)DM * DFF;
constexpr size_t W_IN0 = 0, W_MEM0 = W_IN0 + E_WIN, W_MEM1 = W_MEM0 + E_WMEM, W_IN1 = W_MEM1 + E_WMEM;
constexpr size_t W_BR0 = W_IN1 + E_WIN, W_BR1 = W_BR0 + E_WBR, W_MIX0 = W_BR1 + E_WBR, W_MIX1 = W_MIX0 + E_WMIX;
constexpr size_t W_FFI0 = W_MIX1 + E_WMIX, W_FFI1 = W_FFI0 + E_WFFI, W_FFO0 = W_FFI1 + E_WFFI, W_FFO1 = W_FFO0 + E_WFFO, W_END = W_FFO1 + E_WFFO;
static_assert(W_END * 2 <= 74 * MiB, "weights fit");
constexpr size_t WS_ACT1 = 82 * MiB;
constexpr size_t WS_MEMB = WS_ACT1 + (size_t)MR * DM * 2;
static_assert(WS_MEMB + (size_t)1024 * 1024 * 2 <= 117 * MiB, "act1+memb");
constexpr size_t WS_PROJ = 117 * MiB;
static_assert((size_t)MR * LDP * 2 <= 204 * MiB, "proj");
constexpr size_t WS_YBR = 321 * MiB;
constexpr size_t WS_TMP = 370 * MiB;
constexpr size_t WS_XF = 435 * MiB;
constexpr size_t WS_MEMKV = 500 * MiB;
constexpr size_t WS_END = 504 * MiB;

typedef unsigned short bf16_t;
typedef float f32x4 __attribute__((ext_vector_type(4)));
typedef float f32x2 __attribute__((ext_vector_type(2)));
typedef unsigned u32x4 __attribute__((ext_vector_type(4)));
typedef unsigned u32x2 __attribute__((ext_vector_type(2)));
typedef short bf16x8 __attribute__((ext_vector_type(8)));
#define LAS __attribute__((address_space(3)))
#define DI __device__ __forceinline__

DI int opaque_tid() { int t = threadIdx.x; asm volatile("" : "+v"(t)); return t; }
DI float bf2f(bf16_t v) { return __uint_as_float(((unsigned)v) << 16); }
DI unsigned f2bf(float f) { unsigned u = __float_as_uint(f); return (u + 0x7fffu + ((u >> 16) & 1u)) >> 16; }
DI unsigned pk2(float lo, float hi) { return f2bf(lo) | (f2bf(hi) << 16); }
DI float lo_bf(unsigned w) { return __uint_as_float(w << 16); }
DI float hi_bf(unsigned w) { return __uint_as_float(w & 0xffff0000u); }
DI float sigmoidf_(float x) { return 1.0f / (1.0f + __expf(-x)); }
DI float logsigmoidf_(float x) { return fminf(x, 0.f) - log1pf(__expf(-fabsf(x))); }
DI float wave_sum(float v) {
#pragma unroll
    for (int o = 1; o < 64; o <<= 1) v += __shfl_xor(v, o);
    return v;
}
DI float wave_max(float v) {
#pragma unroll
    for (int o = 1; o < 64; o <<= 1) v = fmaxf(v, __shfl_xor(v, o));
    return v;
}

struct Params {
    const float* in[23];
    float* out;
    unsigned char* ws;
    int G;
    int pad;
};
typedef const __attribute__((address_space(4))) Params* CP;

namespace pg8 {
#define PG8_LAS __attribute__((address_space(3)))
constexpr int BM = 256, BK = 64, HALF = 128, HTB = HALF * BK * 2  , STAGE_BYTES = 8 * HTB, NXCD = 8, WGM = 8;

__host__ __device__ __forceinline__ int lds_byte(int r, int c) { const int st = (r >> 4) * 2 + (c >> 5), rr = r & 15, cc = c & 31, ob = rr * 64 + cc * 2; return st * 1024 + (ob ^ (((ob >> 9) & 1) << 5)); }
__host__ __device__ __forceinline__ void stage_rc(int b, int& R, int& C) { const int st = b / 1024, sb = b % 1024, swz = sb ^ (((sb >> 9) & 1) << 5); R = (st >> 1) * 16 + swz / 64; C = (st & 1) * 32 + (swz % 64) / 2; }
__host__ __device__ __forceinline__ int perm32(int rho) { const int n = rho >> 4, i = rho & 15; return 8 * (i >> 2) + 4 * n + (i & 3); }

struct Unit { int pm, pn, ko; };
struct Gemm { const bf16_t* A; const bf16_t* Bt; int lda, ldb, K; };

template <int REP> struct Sched {
    int nM, nN, nwg, G, c, kseg, nextra;
    __device__ __forceinline__ void init(int nM_, int nN_, int G_, int c_, int kseg_, int nextra_) { nM = nM_; nN = nN_; nwg = nM * nN; G = G_; c = c_; kseg = kseg_; nextra = nextra_; }
    __device__ __forceinline__ bool next(int i, Unit& u) const {
        const int ti = i / REP, r = i - ti * REP;
        const long L = (long)ti * G + c;
        if (L < nwg) {
            int wgid = (int)L; { const int q = nwg / NXCD, rr = nwg % NXCD, xcd = wgid % NXCD, off = wgid / NXCD; wgid = (xcd < rr ? xcd * (q + 1) : rr * (q + 1) + (xcd - rr) * q) + off; }
            const int nig = WGM * nN, gid = wgid / nig, fm = gid * WGM, gsz = (nM - fm) < WGM ? (nM - fm) : WGM;
            u.pm = fm + ((wgid % nig) % gsz); u.pn = (wgid % nig) / gsz; u.ko = r * kseg; return true;
        }
        const int e = (int)(L - nwg); if (e >= nextra) return false;
        u.pm = NRT + ((e >> 2) & 3); u.pn = 26 + (e >> 4) * 4 + (e & 3); u.ko = 0; return true;
    }
    __device__ __forceinline__ void a_ready(const Unit&) const {}
    __device__ __forceinline__ void done(const Unit&) const {}
};

__device__ __forceinline__ unsigned cvt_pk_bf16(float lo, float hi) { unsigned r; asm volatile("v_cvt_pk_bf16_f32 %0, %1, %2" : "=v"(r) : "v"(lo), "v"(hi)); return r; }


struct EpiProj {
    static constexpr bool PERM = true, AFTER_DRAIN = false;
    bf16_t* proj; float* gates; const float* rope; float* out; bf16_t* memkv; int layer;
    __device__ __forceinline__ void operator()(const f32x4 (&acc)[2][2][4][2], const Unit& u, int wr, int wc, int fr, int fq) const {
        const int row0 = u.pm * BM + wr * 64 + fr, cit = wc * 32 + 8 * fq;
        if (u.pm < NRT) {
            if (u.pn == 25) {
                if (wc == 0 && fq == 0) {
#pragma unroll
                    for (int ai = 0; ai < 2; ++ai)
#pragma unroll
                        for (int m = 0; m < 4; ++m) { float* gp = gates + (size_t)(row0 + ai * HALF + m * 16) * 8; *(f32x4*)gp = acc[ai][0][m][0]; *(f32x4*)(gp + 4) = acc[ai][0][m][1]; }
                }
                return;
            }
            const bool ropeq = (u.pn == 8 || u.pn == 9), ropek = (u.pn == 10);
#pragma unroll
            for (int ai = 0; ai < 2; ++ai)
#pragma unroll
                for (int m = 0; m < 4; ++m) {
                    const int row = row0 + ai * HALF + m * 16;
#pragma unroll
                    for (int bj = 0; bj < 2; ++bj) {
                        f32x4 v0 = acc[ai][bj][m][0], v1 = acc[ai][bj][m][1];
                        if (ropeq || (ropek && bj == 0)) {
                            f32x4 p0, p1;
#pragma unroll
                            for (int k = 0; k < 4; ++k) { p0[k] = __shfl_xor(v0[k], 16); p1[k] = __shfl_xor(v1[k], 16); }
                            if ((wc & 1) == 0 && fq < 2) {
                                const int pidx = (u.pm < 64) ? (row & (SEQ - 1)) : SEQ;
                                const float* rp = rope + (size_t)pidx * 16;
                                const f32x4 c0 = *(const f32x4*)rp, c1 = *(const f32x4*)(rp + 4), s0 = *(const f32x4*)(rp + 8), s1 = *(const f32x4*)(rp + 12);
                                if (fq == 0) { v0 = v0 * c0 - p0 * s0; v1 = v1 * c1 - p1 * s1; }
                                else         { v0 = v0 * c0 + p0 * s0; v1 = v1 * c1 + p1 * s1; }
                            }
                        }
                        u32x4 w; w.x = cvt_pk_bf16(v0[0], v0[1]); w.y = cvt_pk_bf16(v0[2], v0[3]); w.z = cvt_pk_bf16(v1[0], v1[1]); w.w = cvt_pk_bf16(v1[2], v1[3]);
                        *(u32x4*)(proj + (size_t)row * LDP + u.pn * BM + bj * HALF + cit) = w;
                        if (ropek) {
                            float* dst = nullptr;
                            if (u.pm < 64) { if ((u.pm & 15) == 15 && ai == 1) dst = out + (bj ? O_SVP : O_SKP) + ((size_t)(layer * NB + (u.pm >> 4)) * 128 + ((row & (SEQ - 1)) - (SEQ - 128))) * 128 + cit; }
                            else if (ai == 0) dst = out + (bj ? O_SVS : O_SKS) + ((size_t)(layer * SB + (row - MP)) * 128 + 127) * 128 + cit;
                            if (dst) { *(f32x4*)dst = v0; *(f32x4*)(dst + 4) = v1; }
                        }
                    }
                }
        } else {
            const int b = u.pm - NRT, q = u.pn - 26, lw = q >> 2, ct = q & 3;
#pragma unroll
            for (int ai = 0; ai < 2; ++ai)
#pragma unroll
                for (int m = 0; m < 4; ++m) {
                    const int mt = wr * 64 + fr + ai * HALF + m * 16;
#pragma unroll
                    for (int bj = 0; bj < 2; ++bj) {
                        const f32x4 v0 = acc[ai][bj][m][0], v1 = acc[ai][bj][m][1];
                        const int col = ct * BM + bj * HALF + cit;
                        float* dst = out + (col < 512 ? O_MKP : O_MVP) + ((size_t)(lw * NB + b) * MEMT + mt) * 512 + (col & 511);
                        *(f32x4*)dst = v0; *(f32x4*)(dst + 4) = v1;
                        u32x4 w; w.x = cvt_pk_bf16(v0[0], v0[1]); w.y = cvt_pk_bf16(v0[2], v0[3]); w.z = cvt_pk_bf16(v1[0], v1[1]); w.w = cvt_pk_bf16(v1[2], v1[3]);
                        *(u32x4*)(memkv + ((size_t)lw * 1024 + b * MEMT + mt) * 1024 + col) = w;
                    }
                }
        }
    }
};

struct EpiBranch {
    static constexpr bool PERM = true, AFTER_DRAIN = false;
    const bf16_t* proj; float* tmp; bf16_t* S;
    __device__ __forceinline__ void operator()(const f32x4 (&acc)[2][2][4][2], const Unit& u, int wr, int wc, int fr, int fq) const {
        const int row0 = u.pm * BM + wr * 64 + fr, cit = wc * 32 + 8 * fq, r = u.ko >> 9;
#pragma unroll
        for (int ai = 0; ai < 2; ++ai)
#pragma unroll
            for (int m = 0; m < 4; ++m) {
                const int row = row0 + ai * HALF + m * 16;
#pragma unroll
                for (int bj = 0; bj < 2; ++bj) {
                    const int col = u.pn * BM + bj * HALF + cit;
                    const u32x4 g = *(const u32x4*)(proj + (size_t)row * LDP + C_GL + r * 1024 + col);
                    f32x4 v0 = acc[ai][bj][m][0], v1 = acc[ai][bj][m][1];
                    v0[0] *= sigmoidf_(lo_bf(g.x)); v0[1] *= sigmoidf_(hi_bf(g.x)); v0[2] *= sigmoidf_(lo_bf(g.y)); v0[3] *= sigmoidf_(hi_bf(g.y));
                    v1[0] *= sigmoidf_(lo_bf(g.z)); v1[1] *= sigmoidf_(hi_bf(g.z)); v1[2] *= sigmoidf_(lo_bf(g.w)); v1[3] *= sigmoidf_(hi_bf(g.w));
                    float* tp = tmp + (size_t)row * DM + col;
                    if (r > 0) { v0 += *(const f32x4*)tp; v1 += *(const f32x4*)(tp + 4); }
                    if (r < 2) { *(f32x4*)tp = v0; *(f32x4*)(tp + 4) = v1; }
                    else { u32x4 w; w.x = cvt_pk_bf16(v0[0], v0[1]); w.y = cvt_pk_bf16(v0[2], v0[3]); w.z = cvt_pk_bf16(v1[0], v1[1]); w.w = cvt_pk_bf16(v1[2], v1[3]);
                           *(u32x4*)(S + (size_t)row * DM + col) = w; }
                }
            }
    }
};

struct EpiRes {
    static constexpr bool PERM = false, AFTER_DRAIN = false;
    const float* resP; const float* resS; float* outp;
    __device__ __forceinline__ void operator()(const f32x4 (&acc)[2][2][4][2], const Unit& u, int wr, int wc, int fr, int fq) const {
        const int row0 = u.pm * BM + wr * 64 + fr, col0 = u.pn * BM + wc * 32 + 4 * fq;
#pragma unroll
        for (int ai = 0; ai < 2; ++ai)
#pragma unroll
            for (int m = 0; m < 4; ++m) {
                const int row = row0 + ai * HALF + m * 16;
                const float* rp = (row < MP ? resP + (size_t)row * DM : resS + (size_t)(row - MP) * DM) + col0;
                float* op = outp + (size_t)row * DM + col0;
#pragma unroll
                for (int bj = 0; bj < 2; ++bj)
#pragma unroll
                    for (int n = 0; n < 2; ++n) *(f32x4*)(op + bj * HALF + n * 16) = *(const f32x4*)(rp + bj * HALF + n * 16) * ALPHA + acc[ai][bj][m][n];
            }
    }
};

struct EpiSwiglu {
    static constexpr bool PERM = true, AFTER_DRAIN = false;
    bf16_t* H;
    __device__ __forceinline__ void operator()(const f32x4 (&acc)[2][2][4][2], const Unit& u, int wr, int wc, int fr, int fq) const {
        const int row0 = u.pm * BM + wr * 64 + fr, cit = wc * 32 + 8 * fq;
#pragma unroll
        for (int ai = 0; ai < 2; ++ai)
#pragma unroll
            for (int m = 0; m < 4; ++m) {
                const int row = row0 + ai * HALF + m * 16;
                f32x4 h0, h1;
#pragma unroll
                for (int k = 0; k < 4; ++k) { const float g0 = acc[ai][0][m][0][k], g1 = acc[ai][0][m][1][k];
                    h0[k] = g0 * sigmoidf_(g0) * acc[ai][1][m][0][k]; h1[k] = g1 * sigmoidf_(g1) * acc[ai][1][m][1][k]; }
                u32x4 w; w.x = cvt_pk_bf16(h0[0], h0[1]); w.y = cvt_pk_bf16(h0[2], h0[3]); w.z = cvt_pk_bf16(h1[0], h1[1]); w.w = cvt_pk_bf16(h1[2], h1[3]);
                *(u32x4*)(H + (size_t)row * DFF + u.pn * HALF + cit) = w;
            }
    }
};

template <class Epi, class Sched, bool ALIGN_EPI = false, bool SP2 = false>
__device__ __forceinline__ void gemm_phase(PG8_LAS unsigned char* lds, const Gemm g, const Sched& S, const Epi& E) {
    const int tid = opaque_tid(), wid = __builtin_amdgcn_readfirstlane(tid >> 6), lane = tid & 63, wr = wid >> 2, wc = wid & 3, fr = lane & 15, fq = lane >> 4;
    const int K = g.K, nt = K / BK;
    unsigned voffA[2], voffB[2];
#pragma unroll
    for (int i = 0; i < 2; ++i) { int R, C; stage_rc(tid * 16 + i * 8192, R, C); const int Rb = Epi::PERM ? ((R & ~31) + perm32(R & 31)) : R;
        voffA[i] = (unsigned)(R * g.lda + C) * 2u; voffB[i] = (unsigned)(Rb * g.ldb + C) * 2u; }
    const size_t kstep = (size_t)(BK * 2);
    const size_t hstepA = (size_t)HALF * g.lda * 2, hstepB = (size_t)HALF * g.ldb * 2;
    const size_t tstepA = 2 * hstepA, tstepB = 2 * hstepB;
    const unsigned ldsw = (unsigned)wid * 1024u;
    const int aoff = lds_byte(wr * 64 + fr, fq * 8), boff = lds_byte(wc * 32 + fr, fq * 8);
#define PG8_SA(b, h) (((b) * 2 + (h)) * HTB)
#define PG8_SB(b, h) ((4 + (b) * 2 + (h)) * HTB)
#define PG8_STAGE(bufoff, gbase, voff) do { _Pragma("unroll") for (int _i = 0; _i < 2; ++_i) \
        __builtin_amdgcn_global_load_lds((const unsigned*)((const char*)(gbase) + (voff)[_i]), (PG8_LAS unsigned*)(lds + (bufoff) + ldsw + _i * 8192), 16, 0, 0); } while (0)
#define PG8_LDA(dst, b, h) do { _Pragma("unroll") for (int m = 0; m < 4; ++m) _Pragma("unroll") for (int k = 0; k < 2; ++k) dst[m][k] = *(const PG8_LAS bf16x8*)(lds + PG8_SA(b, h) + aoff + m * 2048 + k * 1024); } while (0)
#define PG8_LDB(dst, b, h) do { _Pragma("unroll") for (int n = 0; n < 2; ++n) _Pragma("unroll") for (int k = 0; k < 2; ++k) dst[n][k] = *(const PG8_LAS bf16x8*)(lds + PG8_SB(b, h) + boff + n * 2048 + k * 1024); } while (0)
#define PG8_MMA(ai, bj, At, Bt) do { __builtin_amdgcn_s_setprio(1); _Pragma("unroll") for (int m = 0; m < 4; ++m) _Pragma("unroll") for (int n = 0; n < 2; ++n) _Pragma("unroll") for (int k = 0; k < 2; ++k) \
        acc[ai][bj][m][n] = __builtin_amdgcn_mfma_f32_16x16x32_bf16(Bt[n][k], At[m][k], acc[ai][bj][m][n], 0, 0, 0); __builtin_amdgcn_s_setprio(0); } while (0)
#define PG8_WAIT_V(n) asm volatile("s_waitcnt vmcnt(" #n ")" ::: "memory")
#define PG8_WAIT_L(n) asm volatile("s_waitcnt lgkmcnt(" #n ")" ::: "memory")
#define PG8_BAR __builtin_amdgcn_s_barrier()
#define PG8_SCHED __builtin_amdgcn_sched_barrier(0)
    Unit cur, nxt; int ui = 0;
    if (!S.next(0, cur)) return;
    f32x4 acc[2][2][4][2];
#pragma unroll
    for (int a = 0; a < 2; ++a)
#pragma unroll
        for (int b = 0; b < 2; ++b)
#pragma unroll
            for (int m = 0; m < 4; ++m)
#pragma unroll
                for (int n = 0; n < 2; ++n) acc[a][b][m][n] = (f32x4){0.f, 0.f, 0.f, 0.f};
    bf16x8 At[4][2], B0[2][2], B1[2][2];
    const char* cA = (const char*)g.A + (size_t)cur.pm * tstepA + (size_t)cur.ko * 2; const char* cB = (const char*)g.Bt + (size_t)cur.pn * tstepB + (size_t)cur.ko * 2;
    S.a_ready(cur);
    if constexpr (SP2) {
        PG8_STAGE(PG8_SB(0, 0), cB, voffB); PG8_STAGE(PG8_SB(0, 1), cB + hstepB, voffB); PG8_STAGE(PG8_SA(0, 0), cA, voffA); PG8_STAGE(PG8_SA(0, 1), cA + hstepA, voffA);
        if (wr == 1) PG8_BAR;
        PG8_WAIT_V(2); PG8_BAR;
        PG8_STAGE(PG8_SB(1, 0), cB + kstep, voffB); PG8_STAGE(PG8_SA(1, 0), cA + kstep, voffA); PG8_STAGE(PG8_SB(1, 1), cB + hstepB + kstep, voffB);
        PG8_WAIT_V(6); PG8_BAR;
    } else {
        PG8_STAGE(PG8_SB(0, 0), cB, voffB); PG8_STAGE(PG8_SA(0, 0), cA, voffA); PG8_STAGE(PG8_SB(0, 1), cB + hstepB, voffB); PG8_STAGE(PG8_SA(0, 1), cA + hstepA, voffA);
        if (wr == 1) PG8_BAR;
        PG8_WAIT_V(4); PG8_BAR;
        PG8_STAGE(PG8_SB(1, 0), cB + kstep, voffB); PG8_STAGE(PG8_SA(1, 0), cA + kstep, voffA); PG8_STAGE(PG8_SB(1, 1), cB + hstepB + kstep, voffB);
        PG8_WAIT_V(6); PG8_BAR;
    }
    for (;;) {
        const bool has_next = S.next(ui + 1, nxt);
        const char* nA = has_next ? (const char*)g.A + (size_t)nxt.pm * tstepA + (size_t)nxt.ko * 2 : cA; const char* nB = has_next ? (const char*)g.Bt + (size_t)nxt.pn * tstepB + (size_t)nxt.ko * 2 : cB;
        for (int t = 0; t < nt; t += 2) {
            const bool last = (t == nt - 2);
            const char* a1 = cA + (size_t)(t + 1) * kstep;
            const char* a2 = last ? nA : cA + (size_t)(t + 2) * kstep; const char* b2 = last ? nB : cB + (size_t)(t + 2) * kstep;
            const char* a3 = a2 + kstep; const char* b3 = b2 + kstep;
            if (last && has_next) S.a_ready(nxt);
            if constexpr (SP2) {
            PG8_LDB(B0, 0, 0); PG8_LDB(B1, 0, 1); PG8_SCHED; PG8_LDA(At, 0, 0); PG8_STAGE(PG8_SA(1, 1), a1 + hstepA, voffA);
            PG8_WAIT_V(8); PG8_WAIT_L(0); PG8_BAR; PG8_MMA(0, 0, At, B0); PG8_MMA(0, 1, At, B1); PG8_BAR; PG8_SCHED;
            PG8_LDA(At, 0, 1); PG8_STAGE(PG8_SB(0, 0), b2, voffB); PG8_STAGE(PG8_SB(0, 1), b2 + hstepB, voffB); PG8_STAGE(PG8_SA(0, 0), a2, voffA);
            PG8_WAIT_V(8); PG8_WAIT_L(0); PG8_BAR; PG8_MMA(1, 0, At, B0); PG8_MMA(1, 1, At, B1); PG8_BAR; PG8_SCHED;
            PG8_LDB(B0, 1, 0); PG8_LDB(B1, 1, 1); PG8_SCHED; PG8_LDA(At, 1, 0); PG8_STAGE(PG8_SA(0, 1), a2 + hstepA, voffA);
            PG8_WAIT_V(8); PG8_WAIT_L(0); PG8_BAR; PG8_MMA(0, 0, At, B0); PG8_MMA(0, 1, At, B1); PG8_BAR; PG8_SCHED;
            PG8_LDA(At, 1, 1); PG8_STAGE(PG8_SB(1, 0), b3, voffB); PG8_STAGE(PG8_SB(1, 1), b3 + hstepB, voffB); PG8_STAGE(PG8_SA(1, 0), a3, voffA);
            PG8_WAIT_V(8); PG8_WAIT_L(0); PG8_BAR; PG8_MMA(1, 0, At, B0); PG8_MMA(1, 1, At, B1); PG8_BAR; PG8_SCHED;
            } else {
            PG8_LDB(B0, 0, 0); PG8_SCHED; PG8_LDA(At, 0, 0); PG8_STAGE(PG8_SA(1, 1), a1 + hstepA, voffA);
            PG8_WAIT_L(8); PG8_BAR; PG8_WAIT_L(0); PG8_MMA(0, 0, At, B0); PG8_BAR; PG8_SCHED;
            PG8_LDB(B1, 0, 1); PG8_STAGE(PG8_SB(0, 0), b2, voffB);
            PG8_BAR; PG8_WAIT_L(0); PG8_MMA(0, 1, At, B1); PG8_BAR;
            PG8_LDA(At, 0, 1); PG8_STAGE(PG8_SA(0, 0), a2, voffA);
            PG8_BAR; PG8_WAIT_L(0); PG8_MMA(1, 0, At, B0); PG8_BAR; PG8_SCHED;
            PG8_STAGE(PG8_SB(0, 1), b2 + hstepB, voffB);
            PG8_WAIT_V(6); PG8_BAR; PG8_MMA(1, 1, At, B1); PG8_BAR;
            PG8_LDB(B0, 1, 0); PG8_SCHED; PG8_LDA(At, 1, 0); PG8_STAGE(PG8_SA(0, 1), a2 + hstepA, voffA);
            PG8_WAIT_L(8); PG8_BAR; PG8_WAIT_L(0); PG8_MMA(0, 0, At, B0); PG8_BAR; PG8_SCHED;
            PG8_LDB(B1, 1, 1); PG8_STAGE(PG8_SB(1, 0), b3, voffB);
            PG8_BAR; PG8_WAIT_L(0); PG8_MMA(0, 1, At, B1); PG8_BAR;
            PG8_LDA(At, 1, 1); PG8_STAGE(PG8_SA(1, 0), a3, voffA);
            PG8_BAR; PG8_WAIT_L(0); PG8_MMA(1, 0, At, B0); PG8_BAR; PG8_SCHED;
            PG8_STAGE(PG8_SB(1, 1), b3 + hstepB, voffB);
            PG8_WAIT_V(6); PG8_BAR; PG8_MMA(1, 1, At, B1); PG8_BAR;
            }
        }
        if constexpr (ALIGN_EPI) { if (wr == 0) PG8_BAR; }
        if constexpr (!Epi::AFTER_DRAIN) { E(acc, cur, wr, wc, fr, fq); S.done(cur); }
        if (!has_next) break;
#pragma unroll
        for (int a = 0; a < 2; ++a)
#pragma unroll
            for (int b = 0; b < 2; ++b)
#pragma unroll
                for (int m = 0; m < 4; ++m)
#pragma unroll
                    for (int n = 0; n < 2; ++n) acc[a][b][m][n] = (f32x4){0.f, 0.f, 0.f, 0.f};
        cur = nxt; cA = nA; cB = nB; ++ui;
        if constexpr (ALIGN_EPI) { if (wr == 1) PG8_BAR; }
    }
    PG8_WAIT_V(0);
    if constexpr (!ALIGN_EPI) { if (wr == 0) PG8_BAR; }
    PG8_BAR;
    if constexpr (Epi::AFTER_DRAIN) { E.fused(acc, cur, wr, wc, fr, fq, lds, wid, lane); S.done(cur); }
#undef PG8_SA
#undef PG8_SB
#undef PG8_STAGE
#undef PG8_LDA
#undef PG8_LDB
#undef PG8_MMA
#undef PG8_WAIT_V
#undef PG8_WAIT_L
#undef PG8_BAR
#undef PG8_SCHED
}
}


#define XB_TMO      128
#define XB_XCNT(j)  (256  + 64 * (j))
#define XB_XSUB(j)  (1280 + 64 * (j))
#define XB_XGEN(j)  (2304 + 64 * (j))
#define XB_TOP      3328
#define XB_TOPGEN   3392
#define XCD_BAR_WORDS 3456
#define XB_SPIN_CAP (1u << 22)
DI unsigned xb_ld(unsigned* p)              { return __hip_atomic_load(p, __ATOMIC_RELAXED, __HIP_MEMORY_SCOPE_AGENT); }
DI unsigned xb_add(unsigned* p, unsigned v) { return __hip_atomic_fetch_add(p, v, __ATOMIC_RELAXED, __HIP_MEMORY_SCOPE_AGENT); }
DI unsigned xb_xcc_id() { return (unsigned)__builtin_amdgcn_s_getreg((3 << 11) | 20) & 0xFu; }
#define XB_SPIN(cond, bar) do { unsigned _sp = 0; while (cond) { __builtin_amdgcn_s_sleep(1); \
    if ((++_sp & 255u) == 0u) { if (xb_ld(&(bar)[XB_TMO])) break; if (_sp > XB_SPIN_CAP) { atomicAdd(&(bar)[XB_TMO], 1u); break; } } } } while (0)
struct XcdBarrier { unsigned* bar; unsigned x; volatile LAS unsigned* st; };
DI XcdBarrier xcd_barrier_post(unsigned* bar, volatile LAS unsigned* st) {
    XcdBarrier b; b.bar = bar; b.x = xb_xcc_id(); b.st = st;
    if (threadIdx.x == 0) (void)xb_add(&bar[XB_XCNT(b.x)], 1u);
    return b;
}
DI void xcd_barrier_complete(unsigned* bar, unsigned x, unsigned& nloc, unsigned& nx) {
    const unsigned G = gridDim.x * gridDim.y * gridDim.z;
    unsigned sum, cnt, mine, sp = 0u;
    for (;;) {
        sum = 0u; cnt = 0u; mine = 0u;
#pragma unroll
        for (unsigned j = 0; j < 16; ++j) { const unsigned c = xb_ld(&bar[XB_XCNT(j)]); sum += c; cnt += (c > 0u) ? 1u : 0u; mine = (j == x) ? c : mine; }
        if (sum == G) break;
        __builtin_amdgcn_s_sleep(1);
        if ((++sp & 255u) == 0u) { if (xb_ld(&bar[XB_TMO])) break; if (sp > XB_SPIN_CAP) { atomicAdd(&bar[XB_TMO], 1u); break; } }
    }
    nloc = mine > 0u ? mine : 1u; nx = cnt > 0u ? cnt : 1u;
}
DI void xcd_barrier(const XcdBarrier& b) {
    asm volatile("s_waitcnt vmcnt(0)" ::: "memory");
    __syncthreads();
    if (threadIdx.x == 0) {
        unsigned* bar = b.bar;
        __builtin_amdgcn_s_waitcnt(0);
        unsigned nloc = b.st[0], nx = b.st[1];
        if (nloc == 0u) { xcd_barrier_complete(bar, b.x, nloc, nx); b.st[0] = nloc; b.st[1] = nx; }
        const unsigned old = xb_add(&bar[XB_XSUB(b.x)], 1u);
        const unsigned gen = old / nloc;
        if (old + 1u == (gen + 1u) * nloc) {
            __builtin_amdgcn_fence(__ATOMIC_RELEASE, "agent");
            asm volatile("s_waitcnt vmcnt(0)" ::: "memory");
            const unsigned og = xb_add(&bar[XB_TOP], 1u);
            const unsigned tg = og / nx;
            if (og + 1u == (tg + 1u) * nx) xb_add(&bar[XB_TOPGEN], 1u);
            else XB_SPIN(xb_ld(&bar[XB_TOPGEN]) == tg, bar);
            __builtin_amdgcn_fence(__ATOMIC_ACQUIRE, "agent");
            xb_add(&bar[XB_XGEN(b.x)], 1u);
            asm volatile("s_waitcnt vmcnt(0)" ::: "memory");
        } else {
            XB_SPIN(xb_ld(&bar[XB_XGEN(b.x)]) == gen, bar);
            __builtin_amdgcn_fence(__ATOMIC_ACQUIRE, "agent");
            asm volatile("s_waitcnt vmcnt(0)" ::: "memory");
        }
    }
    __syncthreads();
}

constexpr int NWAVES = 8, NTHR = 512;
constexpr int LDS_BYTES = 163840;
constexpr int LDS_CTL_OFF = 163840 - 256;
#define LDS_WAIT() asm volatile("s_waitcnt lgkmcnt(0)" ::: "memory")

struct Ptrs {
    float* out; float* rope; float* xs; float* gates; float* misc;
    bf16_t* wb; bf16_t* act1; bf16_t* memb; bf16_t* proj; bf16_t* hbuf; bf16_t* ybr; float* tmp; float* xf; bf16_t* memkv;
};
DI Ptrs make_ptrs(CP p) {
    Ptrs q; unsigned char* ws = p->ws;
    q.out = p->out; q.rope = (float*)(ws + WS_ROPE); q.xs = (float*)(ws + WS_XS); q.gates = (float*)(ws + WS_GATES); q.misc = (float*)(ws + WS_MISC);
    q.wb = (bf16_t*)(ws + WS_WB); q.act1 = (bf16_t*)(ws + WS_ACT1); q.memb = (bf16_t*)(ws + WS_MEMB); q.proj = (bf16_t*)(ws + WS_PROJ); q.hbuf = (bf16_t*)(ws + WS_PROJ);
    q.ybr = (bf16_t*)(ws + WS_YBR); q.tmp = (float*)(ws + WS_TMP); q.xf = (float*)(ws + WS_XF); q.memkv = (bf16_t*)(ws + WS_MEMKV);
    return q;
}

DI int win_src(int n) { return n < 2048 ? n : (n < 6400 ? n + 8 : (n < 6408 ? 2048 + (n - 6400) : -1)); }
DI int ffi_src(int n) { const int T = n >> 8, j = n & 255; return j < 128 ? T * 128 + j : DFF + T * 128 + (j - 128); }

template <int MODE> DI void p0_transpose_item(const float* W, int Nsrc, bf16_t* WT, int ldd, int dcol0, int Ndest, LAS float* scr, int item, int lane) {
    const int nblk = Ndest / 32, kb = item / nblk, nb = item % nblk, k0 = 64 * kb, n0 = 32 * nb;
    const int n = n0 + (lane & 31);
    const int sc = MODE == 1 ? win_src(n) : (MODE == 2 ? ffi_src(n) : n);
    const float scale = (MODE == 1 && n >= 512 && n < 1024) ? 0.08838834764831845f : 1.0f;
#pragma unroll 8
    for (int i = 0; i < 32; ++i) { const int kk = 2 * i + (lane >> 5); scr[kk * 33 + (lane & 31)] = sc >= 0 ? W[(size_t)(k0 + kk) * Nsrc + sc] * scale : 0.f; }
    LDS_WAIT(); asm volatile("" ::: "memory");
    const int c = lane & 7;
#pragma unroll
    for (int j = 0; j < 4; ++j) { const int nn = (lane >> 3) + 8 * j; const LAS float* s = scr + (8 * c) * 33 + nn;
        u32x4 o; o.x = pk2(s[0 * 33], s[1 * 33]); o.y = pk2(s[2 * 33], s[3 * 33]); o.z = pk2(s[4 * 33], s[5 * 33]); o.w = pk2(s[6 * 33], s[7 * 33]);
        *(u32x4*)(WT + (size_t)(n0 + nn) * ldd + dcol0 + k0 + 8 * c) = o; }
    LDS_WAIT(); asm volatile("" ::: "memory");
}

DI void sincos_taylor(double r, double& c, double& s) {
    const double r2 = r * r; double tc = 1.0, ts = r; c = 1.0; s = r;
#pragma unroll
    for (int k = 1; k <= 15; ++k) { tc *= -r2 / (double)((2 * k - 1) * (2 * k)); ts *= -r2 / (double)((2 * k) * (2 * k + 1)); c += tc; s += ts; }
}

DI void phase_prologue(CP p, const Ptrs& q, LAS unsigned char* lds) {
    const int tid = opaque_tid(), lane = tid & 63, wave = tid >> 6;
    const int gw = blockIdx.x * NWAVES + wave, NGW = p->G * NWAVES;
    LAS float* scr = (LAS float*)(lds + wave * 16384);
    constexpr int I_IN = 16 * (NPROJ / 32), I_MEM = 16 * 32, I_BR = 8 * 32, I_MIX = 16 * 32, I_FFI = 16 * (2 * DFF / 32), I_FFO = (DFF / 64) * 32;
    constexpr int PER_L = I_IN + I_MEM + 3 * I_BR + I_MIX + I_FFI + I_FFO;
    for (int it = gw; it < 2 * PER_L; it += NGW) {
        const int l = it / PER_L; int r = it - l * PER_L;
        if (r < I_IN) { p0_transpose_item<1>(p->in[10] + (size_t)l * DM * DIN, DIN, q.wb + (l ? W_IN1 : W_IN0), DM, 0, NPROJ, scr, r, lane); continue; } r -= I_IN;
        if (r < I_MEM) { p0_transpose_item<0>(p->in[14] + (size_t)l * DM * DM, DM, q.wb + (l ? W_MEM1 : W_MEM0), DM, 0, DM, scr, r, lane); continue; } r -= I_MEM;
        if (r < 3 * I_BR) { const int br = r / I_BR; p0_transpose_item<0>(p->in[15] + (size_t)(l * 3 + br) * 512 * DM, DM, q.wb + (l ? W_BR1 : W_BR0), 1536, br * 512, DM, scr, r - br * I_BR, lane); continue; } r -= 3 * I_BR;
        if (r < I_MIX) { p0_transpose_item<0>(p->in[16] + (size_t)l * DM * DM, DM, q.wb + (l ? W_MIX1 : W_MIX0), DM, 0, DM, scr, r, lane); continue; } r -= I_MIX;
        if (r < I_FFI) { p0_transpose_item<2>(p->in[19] + (size_t)l * DM * 2 * DFF, 2 * DFF, q.wb + (l ? W_FFI1 : W_FFI0), DM, 0, 2 * DFF, scr, r, lane); continue; } r -= I_FFI;
        p0_transpose_item<0>(p->in[20] + (size_t)l * DFF * DM, DM, q.wb + (l ? W_FFO1 : W_FFO0), DFF, 0, DM, scr, r, lane);
    }
    for (int m = gw; m < MR + 1024; m += NGW) {
        const float* src = m < MP ? p->in[0] + (size_t)m * DM : (m < MP + SB ? p->in[1] + (size_t)(m - MP) * DM : (m < MR ? nullptr : p->in[2] + (size_t)(m - MR) * DM));
        bf16_t* dst = q.act1 + (size_t)m * DM;
#pragma unroll
        for (int j = 0; j < 4; ++j) {
            const f32x4 v = src ? *(const f32x4*)(src + 4 * lane + 256 * j) : (f32x4){0.f, 0.f, 0.f, 0.f};
            u32x2 w; w.x = pk2(v[0], v[1]); w.y = pk2(v[2], v[3]);
            *(u32x2*)(dst + 4 * lane + 256 * j) = w;
            if (m >= MP && m < MR) *(f32x4*)(q.xs + (size_t)(m - MP) * DM + 4 * lane + 256 * j) = v;
        }
    }
    for (int i = blockIdx.x * NTHR + tid; i < 128 * LDY / 8; i += p->G * NTHR) *(u32x4*)(q.ybr + (size_t)(MP + SB) * LDY + (size_t)i * 8) = (u32x4){0u, 0u, 0u, 0u};
    for (int i = blockIdx.x * NTHR + tid; i < (SEQ + 1) * 8; i += p->G * NTHR) {
        const int pr = i >> 3, f = i & 7; const double pos = pr < SEQ ? (double)pr : (double)PAST;
        const double invf = f == 0 ? 1.0 : f == 1 ? 0.19392274474868576 : f == 2 ? 0.03760603093086393 : f == 3 ? 0.007292664737217109 : f == 4 ? 0.001414213562373095
                          : f == 5 ? 0.0002742481756762073 : f == 6 ? 5.318295896944988e-05 : 1.031338537721246e-05;
        const double ang = pos * invf, k = rint(ang * 0.15915494309189535), r = (ang - k * 6.283185307179586) - k * 2.4492935982947064e-16;
        double c, s; sincos_taylor(r, c, s);
        q.rope[pr * 16 + f] = (float)c; q.rope[pr * 16 + 8 + f] = (float)s;
    }
}

DI void phase_ln(CP p, const float* pre, const float* g, const float* b, float* outP, float* outS, bf16_t* xb) {
    const int tid = opaque_tid(), lane = tid & 63, wave = tid >> 6;
    const int gw = blockIdx.x * NWAVES + wave, NGW = p->G * NWAVES;
    f32x4 gv[4], bv[4];
#pragma unroll
    for (int j = 0; j < 4; ++j) { gv[j] = *(const f32x4*)(g + 4 * lane + 256 * j); bv[j] = *(const f32x4*)(b + 4 * lane + 256 * j); }
    for (int m = gw; m < MP + SB; m += NGW) {
        const float* src = pre + (size_t)m * DM;
        f32x4 v[4]; float s = 0.f;
#pragma unroll
        for (int j = 0; j < 4; ++j) { v[j] = *(const f32x4*)(src + 4 * lane + 256 * j); s += (v[j][0] + v[j][1]) + (v[j][2] + v[j][3]); }
        const float mean = wave_sum(s) * (1.f / DM); float s2 = 0.f;
#pragma unroll
        for (int j = 0; j < 4; ++j) { v[j] = v[j] - mean; s2 += (v[j][0] * v[j][0] + v[j][1] * v[j][1]) + (v[j][2] * v[j][2] + v[j][3] * v[j][3]); }
        const float rstd = 1.0f / sqrtf(wave_sum(s2) * (1.f / DM) + LN_EPS);
        float* dst = m < MP ? outP + (size_t)m * DM : outS + (size_t)(m - MP) * DM;
#pragma unroll
        for (int j = 0; j < 4; ++j) {
            const f32x4 y = v[j] * rstd * gv[j] + bv[j];
            *(f32x4*)(dst + 4 * lane + 256 * j) = y;
            if (xb) { u32x2 w; w.x = pk2(y[0], y[1]); w.y = pk2(y[2], y[3]); *(u32x2*)(xb + (size_t)m * DM + 4 * lane + 256 * j) = w; }
        }
    }
}

DI void mlstm_prompt_naive_unit(CP p, const Ptrs& q, int l, int bh, LAS float* sm) {
    const int tid = opaque_tid(), lane = tid & 63, wid = tid >> 6;
    const int b = bh >> 2, h = bh & 3, v = tid >> 2, part = tid & 3;
    const float bi = p->in[11][l * 8 + h], bfg = p->in[11][l * 8 + 4 + h];
    const float gn = p->in[12][l * 512 + h * 128 + v];
    float C[32], n[32]; float m = 0.f;
#pragma unroll
    for (int j = 0; j < 32; ++j) { C[j] = 0.f; n[j] = 0.f; }
    for (int t = 0; t < SEQ; ++t) {
        const size_t row = (size_t)b * SEQ + t;
        __syncthreads();
        if (tid < 384) { const int which = tid >> 7, d = tid & 127; const int col = (which == 0 ? C_MQ : (which == 1 ? C_MK : C_MV)) + h * 128 + d; sm[tid] = bf2f(q.proj[row * LDP + col]); }
        __syncthreads();
        const float li = q.gates[row * 8 + h] + bi, lf = logsigmoidf_(q.gates[row * 8 + 4 + h] + bfg);
        const float mn = fmaxf(lf + m, li), a = expf(lf + m - mn), w = expf(li - mn);
        const float vv = sm[256 + v] * w;
        float cq = 0.f, nq = 0.f;
#pragma unroll
        for (int j = 0; j < 32; ++j) { const int d = part * 32 + j; const float kd = sm[128 + d], qd = sm[d];
            C[j] = a * C[j] + vv * kd; n[j] = a * n[j] + w * kd; cq += C[j] * qd; nq += n[j] * qd; }
        cq += __shfl_xor(cq, 1); cq += __shfl_xor(cq, 2); nq += __shfl_xor(nq, 1); nq += __shfl_xor(nq, 2);
        const float hval = cq / fmaxf(fabsf(nq), expf(-mn)); m = mn;
        const float s1 = wave_sum(hval) * 0.25f;
        if (lane == 0) sm[384 + wid] = s1;
        __syncthreads();
        float mu = 0.f;
#pragma unroll
        for (int i = 0; i < 8; ++i) mu += sm[384 + i];
        mu *= (1.f / 128.f);
        const float dv = hval - mu; const float s2 = wave_sum(dv * dv) * 0.25f;
        if (lane == 0) sm[392 + wid] = s2;
        __syncthreads();
        float var = 0.f;
#pragma unroll
        for (int i = 0; i < 8; ++i) var += sm[392 + i];
        var *= (1.f / 128.f);
        const float mo = bf2f(q.proj[row * LDP + C_MO + h * 128 + v]);
        const float y = dv * (1.0f / sqrtf(var + HN_EPS)) * gn * sigmoidf_(mo);
        if (part == 0) q.ybr[row * LDY + h * 128 + v] = (bf16_t)f2bf(y);
    }
    float* co = q.out + O_CP + ((size_t)(l * NB + b) * 4 + h) * 16384 + v * 128 + part * 32;
#pragma unroll
    for (int j = 0; j < 32; ++j) co[j] = C[j];
    if (v == 0) { float* no = q.out + O_NP + ((size_t)(l * NB + b) * 4 + h) * 128 + part * 32;
#pragma unroll
        for (int j = 0; j < 32; ++j) no[j] = n[j]; }
    if (tid == 0) q.out[O_MPM + (size_t)(l * NB + b) * 4 + h] = m;
}

DI void swa_prompt_naive_token(CP p, const Ptrs& q, int l, int row, int hd, int lane, LAS float* wsm) {
    const int b = row / SEQ, t = row % SEQ, kvh = hd >> 2;
    wsm[lane] = bf2f(q.proj[(size_t)row * LDP + C_SQ + hd * 64 + lane]);
    LDS_WAIT();
    const float sink = p->in[13][l * 8 + hd];
    float sc[3]; bool ok[3];
#pragma unroll
    for (int i = 0; i < 3; ++i) {
        const int j = lane + 64 * i, s = t - 128 + j; ok[i] = (j <= 128) && (s >= 0); sc[i] = -1e30f;
        if (ok[i]) {
            const bf16_t* kr = q.proj + ((size_t)b * SEQ + s) * LDP + C_SK + kvh * 64; float dot = 0.f;
#pragma unroll
            for (int c = 0; c < 8; ++c) { const u32x4 kk = *(const u32x4*)(kr + 8 * c); const LAS float* qq = wsm + 8 * c;
                dot += qq[0] * lo_bf(kk.x) + qq[1] * hi_bf(kk.x) + qq[2] * lo_bf(kk.y) + qq[3] * hi_bf(kk.y) + qq[4] * lo_bf(kk.z) + qq[5] * hi_bf(kk.z) + qq[6] * lo_bf(kk.w) + qq[7] * hi_bf(kk.w); }
            sc[i] = dot * 0.125f;
        }
    }
    const float mx = fmaxf(wave_max(fmaxf(fmaxf(sc[0], sc[1]), sc[2])), sink);
    float e[3], es = 0.f;
#pragma unroll
    for (int i = 0; i < 3; ++i) { e[i] = ok[i] ? __expf(sc[i] - mx) : 0.f; es += e[i]; }
    const float inv = 1.0f / (wave_sum(es) + __expf(sink - mx));
#pragma unroll
    for (int i = 0; i < 3; ++i) wsm[64 + lane + 64 * i] = e[i] * inv;
    LDS_WAIT();
    float o = 0.f;
    const int j0 = t >= 128 ? 0 : 128 - t;
    for (int j = j0; j <= 128; ++j) { const int s = t - 128 + j; o += wsm[64 + j] * bf2f(q.proj[((size_t)b * SEQ + s) * LDP + C_SV + kvh * 64 + lane]); }
    q.ybr[(size_t)row * LDY + 512 + hd * 64 + lane] = (bf16_t)f2bf(o);
    LDS_WAIT();
}

DI void cross_prompt_naive_token(CP p, const Ptrs& q, int l, int row, int h, int lane, LAS float* wsm) {
    const int b = row / SEQ;
    wsm[lane] = bf2f(q.proj[(size_t)row * LDP + C_XQ + h * 128 + lane]); wsm[64 + lane] = bf2f(q.proj[(size_t)row * LDP + C_XQ + h * 128 + 64 + lane]);
    LDS_WAIT();
    const bf16_t* kv = q.memkv + ((size_t)l * 1024 + b * MEMT) * 1024;
    float sc[4];
#pragma unroll
    for (int i = 0; i < 4; ++i) {
        const bf16_t* kr = kv + (size_t)(lane + 64 * i) * 1024 + h * 128; float dot = 0.f;
#pragma unroll
        for (int c = 0; c < 16; ++c) { const u32x4 kk = *(const u32x4*)(kr + 8 * c); const LAS float* qq = wsm + 8 * c;
            dot += qq[0] * lo_bf(kk.x) + qq[1] * hi_bf(kk.x) + qq[2] * lo_bf(kk.y) + qq[3] * hi_bf(kk.y) + qq[4] * lo_bf(kk.z) + qq[5] * hi_bf(kk.z) + qq[6] * lo_bf(kk.w) + qq[7] * hi_bf(kk.w); }
        sc[i] = dot * 0.08838834764831845f;
    }
    const float mx = wave_max(fmaxf(fmaxf(sc[0], sc[1]), fmaxf(sc[2], sc[3])));
    float e[4], es = 0.f;
#pragma unroll
    for (int i = 0; i < 4; ++i) { e[i] = __expf(sc[i] - mx); es += e[i]; }
    const float inv = 1.0f / wave_sum(es);
#pragma unroll
    for (int i = 0; i < 4; ++i) wsm[128 + lane + 64 * i] = e[i] * inv;
    LDS_WAIT();
    float o0 = 0.f, o1 = 0.f;
    for (int j = 0; j < MEMT; ++j) { const unsigned vv = *(const unsigned*)(kv + (size_t)j * 1024 + 512 + h * 128 + 2 * lane); const float pj = wsm[128 + j]; o0 += pj * lo_bf(vv); o1 += pj * hi_bf(vv); }
    *(unsigned*)(q.ybr + (size_t)row * LDY + 1024 + h * 128 + 2 * lane) = pk2(o0, o1);
    LDS_WAIT();
}

DI void sample_mlstm_unit(CP p, const Ptrs& q, int l, int unit, LAS float* sm) {
    const int tid = opaque_tid(), lane = tid & 63, wid = tid >> 6, b = unit >> 2, h = unit & 3, d4 = lane & 31;
    const size_t row = MP + b;
    __syncthreads();
    if (tid < 128) sm[tid] = bf2f(q.proj[row * LDP + C_MV + h * 128 + tid]);
    const bf16_t* pr = q.proj + row * LDP + h * 128 + 4 * d4;
    const u32x2 qw = *(const u32x2*)(pr + C_MQ), kw = *(const u32x2*)(pr + C_MK);
    const f32x4 q4 = {lo_bf(qw.x), hi_bf(qw.x), lo_bf(qw.y), hi_bf(qw.y)}, k4 = {lo_bf(kw.x), hi_bf(kw.x), lo_bf(kw.y), hi_bf(kw.y)};
    const size_t sidx = (size_t)(l * SB + b) * 4 + h;
    const float m0 = p->in[9][sidx];
    const float li = q.gates[row * 8 + h] + p->in[11][l * 8 + h], lf = logsigmoidf_(q.gates[row * 8 + 4 + h] + p->in[11][l * 8 + 4 + h]);
    const float mn = fmaxf(lf + m0, li), a = expf(lf + m0 - mn), w = expf(li - mn);
    const f32x4 n4 = *(const f32x4*)(p->in[8] + sidx * 128 + 4 * d4);
    const f32x4 nn4 = n4 * a + k4 * w;
    float nq = nn4[0] * q4[0] + nn4[1] * q4[1] + nn4[2] * q4[2] + nn4[3] * q4[3];
#pragma unroll
    for (int o = 1; o < 32; o <<= 1) nq += __shfl_xor(nq, o);
    if (wid == 0 && lane < 32) *(f32x4*)(q.out + O_NS + sidx * 128 + 4 * d4) = nn4;
    if (tid == 0) q.out[O_MS + sidx] = mn;
    const float dn = fmaxf(fabsf(nq), expf(-mn));
    __syncthreads();
    const float* cin = p->in[7] + sidx * 16384; float* cout = q.out + O_CS + sidx * 16384;
    f32x4 c4[8];
#pragma unroll
    for (int i = 0; i < 8; ++i) { const int v = 16 * wid + 2 * i + (lane >> 5); c4[i] = *(const f32x4*)(cin + v * 128 + 4 * d4); }
#pragma unroll
    for (int i = 0; i < 8; ++i) {
        const int v = 16 * wid + 2 * i + (lane >> 5);
        const float wv = w * sm[v];
        const f32x4 cn = c4[i] * a + k4 * wv;
        *(f32x4*)(cout + v * 128 + 4 * d4) = cn;
        float cq = cn[0] * q4[0] + cn[1] * q4[1] + cn[2] * q4[2] + cn[3] * q4[3];
#pragma unroll
        for (int o = 1; o < 32; o <<= 1) cq += __shfl_xor(cq, o);
        if (d4 == 0) sm[128 + v] = cq / dn;
    }
    __syncthreads();
    const float hv = tid < 128 ? sm[128 + tid] : 0.f;
    const float s1 = wave_sum(hv);
    if (lane == 0) sm[256 + wid] = s1;
    __syncthreads();
    const float mu = (sm[256] + sm[257]) * (1.f / 128.f);
    const float dv = tid < 128 ? hv - mu : 0.f;
    const float s2 = wave_sum(dv * dv);
    if (lane == 0) sm[264 + wid] = s2;
    __syncthreads();
    const float var = (sm[264] + sm[265]) * (1.f / 128.f);
    if (tid < 128) {
        const float mo = bf2f(q.proj[row * LDP + C_MO + h * 128 + tid]);
        q.ybr[row * LDY + h * 128 + tid] = (bf16_t)f2bf(dv * (1.0f / sqrtf(var + HN_EPS)) * p->in[12][l * 512 + h * 128 + tid] * sigmoidf_(mo));
    }
}

DI void sample_swa_unit(CP p, const Ptrs& q, int l, int unit, LAS float* sm) {
    const int tid = opaque_tid(), lane = tid & 63, wid = tid >> 6, b = unit >> 1, kvh = unit & 1;
    const size_t row = MP + b;
    LAS float* Kt = sm;
    LAS float* Vt = sm + 129 * 65;
    LAS float* qs = Vt + 129 * 64;
    LAS float* sc = qs + 256;
    __syncthreads();
    const float* ksrc = p->in[3] + ((size_t)(l * SB + b) * 128 * 2 + kvh) * 64;
    const float* vsrc = p->in[4] + ((size_t)(l * SB + b) * 128 * 2 + kvh) * 64;
    float* kdst = q.out + O_SKS + (size_t)(l * SB + b) * 128 * 128 + kvh * 64;
    float* vdst = q.out + O_SVS + (size_t)(l * SB + b) * 128 * 128 + kvh * 64;
#pragma unroll
    for (int it = 0; it < 4; ++it) {
        const int idx = tid + 512 * it, w = idx >> 4, c4 = idx & 15;
        const f32x4 kv = *(const f32x4*)(ksrc + (size_t)w * 128 + 4 * c4), vv = *(const f32x4*)(vsrc + (size_t)w * 128 + 4 * c4);
        Kt[w * 65 + 4 * c4 + 0] = kv[0]; Kt[w * 65 + 4 * c4 + 1] = kv[1]; Kt[w * 65 + 4 * c4 + 2] = kv[2]; Kt[w * 65 + 4 * c4 + 3] = kv[3];
        *(LAS f32x4*)(Vt + w * 64 + 4 * c4) = vv;
        if (w >= 1) { *(f32x4*)(kdst + (size_t)(w - 1) * 128 + 4 * c4) = kv; *(f32x4*)(vdst + (size_t)(w - 1) * 128 + 4 * c4) = vv; }
    }
    if (tid < 64) Kt[128 * 65 + tid] = bf2f(q.proj[row * LDP + C_SK + kvh * 64 + tid]);
    else if (tid < 128) Vt[128 * 64 + tid - 64] = bf2f(q.proj[row * LDP + C_SV + kvh * 64 + tid - 64]);
    else if (tid >= 256) qs[tid - 256] = bf2f(q.proj[row * LDP + C_SQ + (kvh * 4) * 64 + tid - 256]);
    __syncthreads();
    { const int g = tid >> 7, w = tid & 127; float dot = 0.f;
#pragma unroll 16
      for (int d = 0; d < 64; ++d) dot += qs[g * 64 + d] * Kt[w * 65 + d];
      sc[g * 132 + w] = dot * 0.125f;
      if (tid < 4) { float d2 = 0.f; for (int d = 0; d < 64; ++d) d2 += qs[tid * 64 + d] * Kt[128 * 65 + d]; sc[tid * 132 + 128] = d2 * 0.125f; } }
    __syncthreads();
    if (wid < 4) {
        const int g = wid; const float sink = p->in[13][l * 8 + kvh * 4 + g];
        const float s0 = sc[g * 132 + lane], s1 = sc[g * 132 + 64 + lane], s2 = lane == 0 ? sc[g * 132 + 128] : -1e30f;
        const float mx = fmaxf(wave_max(fmaxf(fmaxf(s0, s1), s2)), sink);
        const float e0 = __expf(s0 - mx), e1 = __expf(s1 - mx), e2 = lane == 0 ? __expf(s2 - mx) : 0.f;
        const float inv = 1.0f / (wave_sum(e0 + e1 + e2) + __expf(sink - mx));
        sc[g * 132 + lane] = e0 * inv; sc[g * 132 + 64 + lane] = e1 * inv; if (lane == 0) sc[g * 132 + 128] = e2 * inv;
    }
    __syncthreads();
    if (tid < 256) { const int g = tid >> 6, d = tid & 63; float o = 0.f;
        for (int j = 0; j <= 128; ++j) o += sc[g * 132 + j] * Vt[j * 64 + d];
        q.ybr[row * LDY + 512 + (kvh * 4 + g) * 64 + d] = (bf16_t)f2bf(o); }
}

DI void sample_cross_unit(CP p, const Ptrs& q, int l, int unit, LAS float* sm) {
    const int tid = opaque_tid(), lane = tid & 63, wid = tid >> 6, b = unit >> 2, h = unit & 3, d4 = lane & 31, hs = lane >> 5;
    const size_t row = MP + b;
    const float* kb = p->in[5] + ((size_t)(l * SB + b) * MEMT * 4 + h) * 128;
    const float* vb = p->in[6] + ((size_t)(l * SB + b) * MEMT * 4 + h) * 128;
    const u32x2 qw = *(const u32x2*)(q.proj + row * LDP + C_XQ + h * 128 + 4 * d4);
    const f32x4 q4 = {lo_bf(qw.x), hi_bf(qw.x), lo_bf(qw.y), hi_bf(qw.y)};
    __syncthreads();
    f32x4 k4[16];
#pragma unroll
    for (int i = 0; i < 16; ++i) k4[i] = *(const f32x4*)(kb + (size_t)(32 * wid + 2 * i + hs) * 512 + 4 * d4);
#pragma unroll
    for (int i = 0; i < 16; ++i) {
        float dot = k4[i][0] * q4[0] + k4[i][1] * q4[1] + k4[i][2] * q4[2] + k4[i][3] * q4[3];
#pragma unroll
        for (int o = 1; o < 32; o <<= 1) dot += __shfl_xor(dot, o);
        if (d4 == 0) sm[32 * wid + 2 * i + hs] = dot * 0.08838834764831845f;
    }
#pragma unroll
    for (int i = 0; i < 16; ++i) k4[i] = *(const f32x4*)(vb + (size_t)(32 * wid + 2 * i + hs) * 512 + 4 * d4);
    __syncthreads();
    const float s0 = sm[lane], s1 = sm[64 + lane], s2 = sm[128 + lane], s3 = sm[192 + lane];
    const float mx = wave_max(fmaxf(fmaxf(s0, s1), fmaxf(s2, s3)));
    const float inv = 1.0f / wave_sum(__expf(s0 - mx) + __expf(s1 - mx) + __expf(s2 - mx) + __expf(s3 - mx));
    f32x4 acc = {0.f, 0.f, 0.f, 0.f};
#pragma unroll
    for (int i = 0; i < 16; ++i) { const float pm = __expf(sm[32 * wid + 2 * i + hs] - mx) * inv; acc += k4[i] * pm; }
#pragma unroll
    for (int k = 0; k < 4; ++k) acc[k] += __shfl_xor(acc[k], 32);
    if (lane < 32) *(LAS f32x4*)(sm + 256 + wid * 128 + 4 * d4) = acc;
    __syncthreads();
    if (tid < 128) { float o = 0.f;
#pragma unroll
        for (int w8 = 0; w8 < 8; ++w8) o += sm[256 + w8 * 128 + tid];
        q.ybr[row * LDY + 1024 + h * 128 + tid] = (bf16_t)f2bf(o); }
}

typedef float f32x16 __attribute__((ext_vector_type(16)));
typedef short s16x4 __attribute__((ext_vector_type(4)));
typedef __bf16 bf16x2_t __attribute__((ext_vector_type(2)));
#define MFMA32(a, b, c) __builtin_amdgcn_mfma_f32_32x32x16_bf16((a), (b), (c), 0, 0, 0)
DI int crow(int i, int h) { return (i & 3) + 8 * (i >> 2) + 4 * h; }
DI unsigned cvtpk(float lo, float hi) { f32x2 v = {lo, hi}; bf16x2_t b = __builtin_convertvector(v, bf16x2_t); return __builtin_bit_cast(unsigned, b); }
DI s16x4 ds_tr(const LAS bf16_t* p) { return __builtin_bit_cast(s16x4, __builtin_amdgcn_ds_read_tr16_b64_v4i16((LAS s16x4*)p)); }
DI bf16x8 tr_frag(const LAS bf16_t* T, int pitch, int k_lo, int k_hi, int n0, int lane) {
    const int i = lane & 15, qq = i >> 2, pp = i & 3, g1 = (lane >> 4) & 1;
    const s16x4 lo = ds_tr(T + (k_lo + qq) * pitch + n0 + 16 * g1 + 4 * pp), hi = ds_tr(T + (k_hi + qq) * pitch + n0 + 16 * g1 + 4 * pp);
    return (bf16x8){lo[0], lo[1], lo[2], lo[3], hi[0], hi[1], hi[2], hi[3]};
}
DI bf16x8 pack_step(const f32x16& x, int s) {
    u32x4 w; w.x = cvtpk(x[8 * s], x[8 * s + 1]); w.y = cvtpk(x[8 * s + 2], x[8 * s + 3]); w.z = cvtpk(x[8 * s + 4], x[8 * s + 5]); w.w = cvtpk(x[8 * s + 6], x[8 * s + 7]);
    return __builtin_bit_cast(bf16x8, w);
}

constexpr int ML_KP = 160, ML_RP = 136;
constexpr int MISC_BK = 0, MISC_GG = 512, MISC_MPREV = 1024, MISC_NLOC = 2048, MISC_NST = MISC_NLOC + 512 * 128;
constexpr size_t WS_CLOC = WS_TMP, WS_CST = WS_TMP + 32 * MiB;

DI void ml_gate_scan(CP p, const Ptrs& q, int l, int h, size_t row0, LAS float* bc, LAS float* uu, LAS float* gm, LAS float* xch, int tid, float& Bk, float& G) {
    const int lane = tid & 63, wid = tid >> 6;
    float lf = 0.f, li = 0.f;
    if (tid < 128) { li = q.gates[(row0 + tid) * 8 + h] + p->in[11][l * 8 + h]; lf = logsigmoidf_(q.gates[(row0 + tid) * 8 + 4 + h] + p->in[11][l * 8 + 4 + h]); }
    float c = lf;
#pragma unroll
    for (int o = 1; o < 64; o <<= 1) { const float t = __shfl_up(c, o); if (lane >= o) c += t; }
    if (tid == 63) xch[0] = c;
    __syncthreads();
    if (wid == 1) c += xch[0];
    float u = li - c, g = u;
#pragma unroll
    for (int o = 1; o < 64; o <<= 1) { const float t = __shfl_up(g, o); if (lane >= o) g = fmaxf(g, t); }
    if (tid == 63) xch[1] = g;
    __syncthreads();
    if (wid == 1) g = fmaxf(g, xch[1]);
    if (tid < 128) { bc[tid] = c; uu[tid] = u; gm[tid] = g; }
    __syncthreads();
    Bk = bc[127]; G = gm[127];
}

DI void ml_local_unit(CP p, const Ptrs& q, int l, int unit, LAS unsigned char* lds) {
    const int tid = opaque_tid(), lane = tid & 63, wid = __builtin_amdgcn_readfirstlane(tid >> 6), hh = lane >> 5;
    const int bh = unit >> 5, k = unit & 31, b = bh >> 2, h = bh & 3;
    const size_t row0 = (size_t)b * SEQ + k * 128;
    LAS bf16_t* Kt = (LAS bf16_t*)lds;
    LAS bf16_t* Vt = Kt + 128 * ML_KP;
    LAS float* bc = (LAS float*)(Vt + 128 * ML_KP);
    LAS float* uu = bc + 128; LAS float* gm = uu + 128; LAS float* ee = gm + 128; LAS float* xch = ee + 128;
    __syncthreads();
    float Bk, G;
    ml_gate_scan(p, q, l, h, row0, bc, uu, gm, xch, tid, Bk, G);
    if (tid < 128) ee[tid] = __expf(uu[tid] - G);
    __syncthreads();
#pragma unroll
    for (int it = 0; it < 4; ++it) {
        const int idx = tid + 512 * it, s = idx >> 4, c8 = idx & 15;
        const bf16_t* src = q.proj + (row0 + s) * LDP + h * 128 + 8 * c8;
        const u32x4 kk = *(const u32x4*)(src + C_MK); const u32x4 vv = *(const u32x4*)(src + C_MV);
        const float e = ee[s];
        u32x4 ve; ve.x = cvtpk(lo_bf(vv.x) * e, hi_bf(vv.x) * e); ve.y = cvtpk(lo_bf(vv.y) * e, hi_bf(vv.y) * e); ve.z = cvtpk(lo_bf(vv.z) * e, hi_bf(vv.z) * e); ve.w = cvtpk(lo_bf(vv.w) * e, hi_bf(vv.w) * e);
        *(LAS u32x4*)(Kt + s * ML_KP + 8 * c8) = kk; *(LAS u32x4*)(Vt + s * ML_KP + 8 * c8) = ve;
    }
    __syncthreads();
    const int vt = wid >> 1, dt0 = 2 * (wid & 1);
    f32x16 acc0 = {}, acc1 = {};
#pragma unroll
    for (int ks = 0; ks < 8; ++ks) {
        const bf16x8 af = tr_frag(Vt, ML_KP, 16 * ks + 8 * hh, 16 * ks + 8 * hh + 4, 32 * vt, lane);
        const bf16x8 b0 = tr_frag(Kt, ML_KP, 16 * ks + 8 * hh, 16 * ks + 8 * hh + 4, 32 * dt0, lane);
        const bf16x8 b1 = tr_frag(Kt, ML_KP, 16 * ks + 8 * hh, 16 * ks + 8 * hh + 4, 32 * dt0 + 32, lane);
        acc0 = MFMA32(af, b0, acc0); acc1 = MFMA32(af, b1, acc1);
    }
    float* cl = (float*)(p->ws + WS_CLOC) + (size_t)unit * 16384;
#pragma unroll
    for (int i = 0; i < 16; ++i) { const int v = 32 * vt + crow(i, hh); cl[v * 128 + 32 * dt0 + (lane & 31)] = acc0[i]; cl[v * 128 + 32 * dt0 + 32 + (lane & 31)] = acc1[i]; }
    if (tid < 128) { float a = 0.f;
#pragma unroll 8
        for (int s = 0; s < 128; ++s) a += ee[s] * bf2f(Kt[s * ML_KP + tid]);
        q.misc[MISC_NLOC + unit * 128 + tid] = a; }
    if (tid == 0) { q.misc[MISC_BK + unit] = Bk; q.misc[MISC_GG + unit] = G; }
}

DI void ml_scan_job(CP p, const Ptrs& q, int l, int j, LAS float* sm) {
    const int tid = opaque_tid(), bh = j >> 4, part = j & 15;
    __syncthreads();
    if (tid < 32) { sm[tid] = q.misc[MISC_BK + bh * 32 + tid]; sm[32 + tid] = q.misc[MISC_GG + bh * 32 + tid]; }
    __syncthreads();
    if (tid == 0) { float m = 0.f;
        for (int k = 0; k < 32; ++k) { const float Bk = sm[k], G = sm[32 + k], mx = fmaxf(m, G);
            sm[64 + k] = __expf(m - mx); sm[96 + k] = __expf(G - mx); sm[128 + k] = m; m = Bk + mx; }
        sm[160] = m; }
    __syncthreads();
    const float* cl = (const float*)(p->ws + WS_CLOC) + (size_t)bh * 32 * 16384 + part * 1024 + 2 * tid;
    bf16_t* cs = (bf16_t*)(p->ws + WS_CST) + (size_t)bh * 32 * 16384 + part * 1024 + 2 * tid;
    f32x2 c = {0.f, 0.f};
#pragma unroll 8
    for (int k = 0; k < 32; ++k) { const f32x2 x = *(const f32x2*)(cl + (size_t)k * 16384); c = c * sm[64 + k] + x * sm[96 + k]; *(unsigned*)(cs + (size_t)k * 16384) = cvtpk(c[0], c[1]); }
    *(f32x2*)(q.out + O_CP + ((size_t)l * 16 + bh) * 16384 + part * 1024 + 2 * tid) = c;
    if (part == 0) {
        if (tid < 128) { float n = 0.f;
            for (int k = 0; k < 32; ++k) { n = n * sm[64 + k] + q.misc[MISC_NLOC + (bh * 32 + k) * 128 + tid] * sm[96 + k]; q.misc[MISC_NST + (bh * 32 + k) * 128 + tid] = n; }
            q.out[O_NP + ((size_t)l * 16 + bh) * 128 + tid] = n; }
        if (tid < 32) q.misc[MISC_MPREV + bh * 32 + tid] = sm[128 + tid];
        if (tid == 0) q.out[O_MPM + (size_t)l * 16 + bh] = sm[160];
    }
}

DI void ml_out_unit(CP p, const Ptrs& q, int l, int unit, LAS unsigned char* lds) {
    const int tid = opaque_tid(), lane = tid & 63, wid = __builtin_amdgcn_readfirstlane(tid >> 6), hh = lane >> 5, r32 = lane & 31;
    const int bh = unit >> 5, k = unit & 31, b = bh >> 2, h = bh & 3;
    const size_t row0 = (size_t)b * SEQ + k * 128;
    LAS bf16_t* Kt = (LAS bf16_t*)lds;
    LAS bf16_t* Vt = Kt + 128 * ML_RP;
    LAS bf16_t* Ct = Vt + 128 * ML_KP;
    LAS float* bc = (LAS float*)(Ct + 128 * ML_RP);
    LAS float* uu = bc + 128; LAS float* gm = uu + 128; LAS float* np = gm + 128; LAS float* xch = np + 128; LAS float* red = xch + 8;
    __syncthreads();
    float Bk, G;
    ml_gate_scan(p, q, l, h, row0, bc, uu, gm, xch, tid, Bk, G);
    const float mprev = k ? q.misc[MISC_MPREV + unit] : 0.f;
    if (tid < 128) np[tid] = k ? q.misc[MISC_NST + (unit - 1) * 128 + tid] : 0.f;
    const bf16_t* cprev = (const bf16_t*)(p->ws + WS_CST) + (size_t)(unit - 1) * 16384;
#pragma unroll
    for (int it = 0; it < 4; ++it) {
        const int idx = tid + 512 * it, s = idx >> 4, c8 = idx & 15;
        const bf16_t* src = q.proj + (row0 + s) * LDP + h * 128 + 8 * c8;
        *(LAS u32x4*)(Kt + s * ML_RP + 8 * c8) = *(const u32x4*)(src + C_MK);
        *(LAS u32x4*)(Vt + s * ML_KP + 8 * c8) = *(const u32x4*)(src + C_MV);
        *(LAS u32x4*)(Ct + s * ML_RP + 8 * c8) = k ? *(const u32x4*)(cprev + s * 128 + 8 * c8) : (u32x4){0u, 0u, 0u, 0u};
    }
    __syncthreads();
    const int tt = wid & 3, vh = wid >> 2, t = 32 * tt + r32;
    bf16x8 qf[8];
    { const bf16_t* qr = q.proj + (row0 + t) * LDP + C_MQ + h * 128 + 8 * hh;
#pragma unroll
      for (int kk = 0; kk < 8; ++kk) qf[kk] = *(const bf16x8*)(qr + 16 * kk); }
    const float gpm = fmaxf(mprev, gm[t]);
    float nq = 0.f;
#pragma unroll
    for (int kk = 0; kk < 8; ++kk)
#pragma unroll
        for (int j = 0; j < 8; ++j) nq += np[16 * kk + 8 * hh + j] * bf2f((bf16_t)qf[kk][j]);
    nq += __shfl_xor(nq, 32);
    bf16x8 pw[4][2]; float rs = 0.f;
#pragma unroll
    for (int st = 0; st < 4; ++st) {
        if (st <= tt) {
            f32x16 sT = {};
#pragma unroll
            for (int kk = 0; kk < 8; ++kk) { const bf16x8 kf = *(const LAS bf16x8*)(Kt + (32 * st + r32) * ML_RP + 16 * kk + 8 * hh); sT = MFMA32(kf, qf[kk], sT); }
#pragma unroll
            for (int i = 0; i < 16; ++i) { const int s = 32 * st + crow(i, hh); const float w = (s <= t) ? __expf(uu[s] - gpm) : 0.f; sT[i] *= w; rs += sT[i]; }
            pw[st][0] = pack_step(sT, 0); pw[st][1] = pack_step(sT, 1);
        } else { pw[st][0] = (bf16x8){0, 0, 0, 0, 0, 0, 0, 0}; pw[st][1] = pw[st][0]; }
    }
    rs += __shfl_xor(rs, 32);
    const float a_t = __expf(mprev - gpm), m_t = bc[t] + gpm;
    const float hden = 1.0f / fmaxf(fabsf(rs + a_t * nq), __expf(-m_t));
    f32x16 hv[2];
#pragma unroll
    for (int vi = 0; vi < 2; ++vi) {
        const int vt = 2 * vh + vi;
        f32x16 num = {}, inter = {};
#pragma unroll
        for (int st = 0; st < 4; ++st)
            if (st <= tt) {
#pragma unroll
                for (int s16 = 0; s16 < 2; ++s16) { const bf16x8 vf = tr_frag(Vt, ML_KP, 32 * st + 16 * s16 + 4 * hh, 32 * st + 16 * s16 + 8 + 4 * hh, 32 * vt, lane); num = MFMA32(vf, pw[st][s16], num); }
            }
#pragma unroll
        for (int kk = 0; kk < 8; ++kk) { const bf16x8 cf = *(const LAS bf16x8*)(Ct + (32 * vt + r32) * ML_RP + 16 * kk + 8 * hh); inter = MFMA32(cf, qf[kk], inter); }
        hv[vi] = (num + inter * a_t) * hden;
    }
    float s1 = 0.f;
#pragma unroll
    for (int vi = 0; vi < 2; ++vi)
#pragma unroll
        for (int i = 0; i < 16; ++i) s1 += hv[vi][i];
    s1 += __shfl_xor(s1, 32);
    if (hh == 0) red[wid * 32 + r32] = s1;
    __syncthreads();
    const float mu = (red[wid * 32 + r32] + red[(wid ^ 4) * 32 + r32]) * (1.f / 128.f);
    float s2 = 0.f;
#pragma unroll
    for (int vi = 0; vi < 2; ++vi)
#pragma unroll
        for (int i = 0; i < 16; ++i) { hv[vi][i] -= mu; s2 += hv[vi][i] * hv[vi][i]; }
    s2 += __shfl_xor(s2, 32);
    if (hh == 0) red[256 + wid * 32 + r32] = s2;
    __syncthreads();
    const float rstd = 1.0f / sqrtf((red[256 + wid * 32 + r32] + red[256 + (wid ^ 4) * 32 + r32]) * (1.f / 128.f) + HN_EPS);
    const float* gn = p->in[12] + l * 512 + h * 128;
#pragma unroll
    for (int vi = 0; vi < 2; ++vi)
#pragma unroll
        for (int i4 = 0; i4 < 4; ++i4) {
            const int v0 = 32 * (2 * vh + vi) + 8 * i4 + 4 * hh;
            const u32x2 mo = *(const u32x2*)(q.proj + (row0 + t) * LDP + C_MO + h * 128 + v0);
            const f32x4 g4 = *(const f32x4*)(gn + v0);
            const float y0 = hv[vi][4 * i4 + 0] * rstd * g4[0] * sigmoidf_(lo_bf(mo.x)), y1 = hv[vi][4 * i4 + 1] * rstd * g4[1] * sigmoidf_(hi_bf(mo.x));
            const float y2 = hv[vi][4 * i4 + 2] * rstd * g4[2] * sigmoidf_(lo_bf(mo.y)), y3 = hv[vi][4 * i4 + 3] * rstd * g4[3] * sigmoidf_(hi_bf(mo.y));
            u32x2 w; w.x = cvtpk(y0, y1); w.y = cvtpk(y2, y3);
            *(u32x2*)(q.ybr + (row0 + t) * LDY + h * 128 + v0) = w;
        }
}

template <int HD, bool SWA> DI void attn_unit(CP p, const Ptrs& q, int l, int unit, LAS unsigned char* lds) {
    constexpr int KP = HD + 8, VP = HD == 128 ? 160 : 96, NK = HD / 16, ND = HD / 32;
    const int tid = opaque_tid(), lane = tid & 63, wid = __builtin_amdgcn_readfirstlane(tid >> 6), hh = lane >> 5, r32 = lane & 31;
    LAS bf16_t* Kt = (LAS bf16_t*)lds;
    LAS bf16_t* Vt = Kt + 256 * KP;
    int b, n = 0, kvh = 0, hx = 0, qb = 0;
    if (SWA) { b = unit >> 6; n = (unit >> 1) & 31; kvh = unit & 1; } else { b = unit >> 6; hx = (unit >> 4) & 3; qb = unit & 15; }
    __syncthreads();
    constexpr int CPR = HD / 8;
#pragma unroll
    for (int it = 0; it < 256 * CPR / NTHR; ++it) {
        const int idx = tid + NTHR * it, key = idx / CPR, c8 = idx % CPR;
        u32x4 kk = {0u, 0u, 0u, 0u}, vv = {0u, 0u, 0u, 0u};
        if (SWA) {
            const int tok = 128 * (n - 1) + key;
            if (tok >= 0) { const bf16_t* src = q.proj + ((size_t)b * SEQ + tok) * LDP + kvh * 64 + 8 * c8; kk = *(const u32x4*)(src + C_SK); vv = *(const u32x4*)(src + C_SV); }
        } else {
            const bf16_t* src = q.memkv + ((size_t)l * 1024 + b * MEMT + key) * 1024 + hx * 128 + 8 * c8; kk = *(const u32x4*)src; vv = *(const u32x4*)(src + 512);
        }
        *(LAS u32x4*)(Kt + key * KP + 8 * c8) = kk; *(LAS u32x4*)(Vt + key * VP + 8 * c8) = vv;
    }
    __syncthreads();
    constexpr int NQT = SWA ? 2 : 1;
    constexpr float SCL = (HD == 64 ? 0.125f : 0.08838834764831845f) * 1.4426950408889634f;
#pragma unroll 1
    for (int qi = 0; qi < NQT; ++qi) {
        int r0, qcol, ocol; size_t qrow;
        if (SWA) { const int qt = wid + 8 * qi, g = qt >> 2; r0 = 32 * (qt & 3); qrow = (size_t)b * SEQ + 128 * n + r0 + r32; qcol = C_SQ + (kvh * 4 + g) * 64; ocol = 512 + (kvh * 4 + g) * 64; }
        else { r0 = 0; qrow = (size_t)b * SEQ + 256 * qb + 32 * wid + r32; qcol = C_XQ + hx * 128; ocol = 1024 + hx * 128; }
        bf16x8 qf[NK];
        { const bf16_t* qr = q.proj + qrow * LDP + qcol + 8 * hh;
#pragma unroll
          for (int kk = 0; kk < NK; ++kk) qf[kk] = *(const bf16x8*)(qr + 16 * kk); }
        constexpr int NKT = SWA ? 5 : 8;
        const int kt0 = SWA ? (r0 >> 5) : 0;
        const int tq = r0 + r32;
        f32x16 sT[NKT];
        float mx = -3.0e38f;
        const LAS bf16_t* kbase = Kt + (32 * kt0 + r32) * KP + 8 * hh;
#pragma unroll
        for (int j = 0; j < NKT; ++j) {
            f32x16 a = {};
#pragma unroll
            for (int kk = 0; kk < NK; ++kk) { const bf16x8 kf = *(const LAS bf16x8*)(kbase + j * 32 * KP + 16 * kk); a = MFMA32(kf, qf[kk], a); }
#pragma unroll
            for (int i = 0; i < 16; ++i) {
                if (SWA) { const int c = 32 * (kt0 + j) + crow(i, hh); const bool ok = (c >= tq) && (c <= tq + 128) && (n > 0 || c >= 128); a[i] = ok ? a[i] : -3.0e38f; }
                mx = fmaxf(mx, a[i]);
            }
            sT[j] = a;
        }
        mx = fmaxf(mx, __shfl_xor(mx, 32));
        float ms = mx * SCL, sinkl = 0.f;
        if (SWA) { sinkl = p->in[13][l * 8 + kvh * 4 + ((wid + 8 * qi) >> 2)] * 1.4426950408889634f; ms = fmaxf(ms, sinkl); }
        float sum = 0.f;
        bf16x8 pw[NKT][2];
#pragma unroll
        for (int j = 0; j < NKT; ++j) {
            f32x16 a = sT[j];
#pragma unroll
            for (int i = 0; i < 16; ++i) { a[i] = __builtin_amdgcn_exp2f(a[i] * SCL - ms); sum += a[i]; }
            pw[j][0] = pack_step(a, 0); pw[j][1] = pack_step(a, 1);
        }
        f32x16 o[ND];
#pragma unroll
        for (int d = 0; d < ND; ++d) o[d] = (f32x16){};
        const LAS bf16_t* vbase = Vt + (32 * kt0 + 4 * hh + ((lane & 15) >> 2)) * VP + 16 * ((lane >> 4) & 1) + 4 * (lane & 3);
#pragma unroll
        for (int j = 0; j < NKT; ++j) {
#pragma unroll
            for (int d = 0; d < ND; ++d) {
                const LAS bf16_t* vb = vbase + j * 32 * VP + 32 * d;
                const s16x4 a0 = ds_tr(vb), a1 = ds_tr(vb + 8 * VP), a2 = ds_tr(vb + 16 * VP), a3 = ds_tr(vb + 24 * VP);
                const bf16x8 v0 = {a0[0], a0[1], a0[2], a0[3], a1[0], a1[1], a1[2], a1[3]}, v1 = {a2[0], a2[1], a2[2], a2[3], a3[0], a3[1], a3[2], a3[3]};
                o[d] = MFMA32(v0, pw[j][0], o[d]); o[d] = MFMA32(v1, pw[j][1], o[d]);
            }
        }
        sum += __shfl_xor(sum, 32);
        if (SWA) sum += __builtin_amdgcn_exp2f(sinkl - ms);
        const float inv = 1.0f / sum;
#pragma unroll
        for (int d = 0; d < ND; ++d)
#pragma unroll
            for (int i4 = 0; i4 < 4; ++i4) {
                const int d0 = 32 * d + 8 * i4 + 4 * hh;
                u32x2 w; w.x = cvtpk(o[d][4 * i4] * inv, o[d][4 * i4 + 1] * inv); w.y = cvtpk(o[d][4 * i4 + 2] * inv, o[d][4 * i4 + 3] * inv);
                *(u32x2*)(q.ybr + qrow * LDY + ocol + d0) = w;
            }
    }
}

#ifndef MK_N_LAUNCHES
#define MK_N_LAUNCHES 1
#endif
#ifndef DBGMASK
#define DBGMASK 0
#endif
#ifndef PHMASK
#define PHMASK 0x1ff
#endif
constexpr int PH_PER_LAYER = 10, N_PHASES = 1 + DEPTH * PH_PER_LAYER;
struct Args { Params p; int ph_lo, ph_hi; };

__global__ void __launch_bounds__(NTHR, 2) mega(Args args) {
    extern __shared__ __attribute__((aligned(16))) unsigned char lds_raw[];
    LAS unsigned char* lds = (LAS unsigned char*)lds_raw;
    const int tid = threadIdx.x;
    volatile LAS unsigned* lctl = (volatile LAS unsigned*)(lds + LDS_CTL_OFF);
    if (tid < 64) lctl[tid] = 0u;
    __syncthreads();
    typedef const __attribute__((address_space(4))) Args* CA;
    CA ap0 = (CA)__builtin_amdgcn_kernarg_segment_ptr();
    unsigned* ctl = (unsigned*)(ap0->p.ws + WS_CTL);
    XcdBarrier bar; bar.bar = ctl + 4096; bar.x = 0; bar.st = nullptr;
    const bool multi = (ap0->ph_hi - ap0->ph_lo) > 1;
    if (multi) bar = xcd_barrier_post(ctl + 4096, lctl);
    LAS float* sm = (LAS float*)lds;

    const int ph_lo = ap0->ph_lo, ph_hi = ap0->ph_hi;
#define PH_BEGIN(k) if (ph_lo <= (k) && (k) < ph_hi) { CA ap = (CA)__builtin_amdgcn_kernarg_segment_ptr(); asm volatile("" : "+s"(ap)); CP p = &ap->p; const Ptrs q = make_ptrs(p); const int G = p->G; (void)q; (void)G;
#define PH_END(k) if ((k) + 1 < ph_hi) xcd_barrier(bar); }
    PH_BEGIN(0) phase_prologue(p, q, lds); PH_END(0)
#define LAYER(l) \
    PH_BEGIN(1 + PH_PER_LAYER * l) { \
        pg8::Gemm g{q.act1, q.wb + (l ? W_IN1 : W_IN0), DM, DM, DM}; \
        pg8::Sched<1> S; S.init(NRT, NPROJ / 256, G, (int)blockIdx.x, 0, l == 0 ? 32 : 0); \
        pg8::EpiProj E{q.proj, q.gates, q.rope, q.out, q.memkv, l}; \
        pg8::gemm_phase<pg8::EpiProj, pg8::Sched<1>, true, true>(lds, g, S, E); } PH_END(1 + PH_PER_LAYER * l) \
    PH_BEGIN(2 + PH_PER_LAYER * l) { \
        for (int u = blockIdx.x; u < 512; u += G) ml_local_unit(p, q, l, u, lds); \
        __syncthreads(); \
        if (!(DBGMASK & 1)) for (int u = blockIdx.x; u < 256; u += G) attn_unit<64, true>(p, q, l, u, lds); \
        if (!(DBGMASK & 2)) for (int u = blockIdx.x; u < 256; u += G) attn_unit<128, false>(p, q, l, u, lds); \
        for (int u = blockIdx.x; u < SB * 4; u += G) sample_mlstm_unit(p, q, l, u, sm); \
        for (int u = blockIdx.x; u < SB * 2; u += G) sample_swa_unit(p, q, l, u, sm); \
        for (int u = blockIdx.x; u < SB * 4; u += G) sample_cross_unit(p, q, l, u, sm); \
        __syncthreads(); } PH_END(2 + PH_PER_LAYER * l) \
    PH_BEGIN(3 + PH_PER_LAYER * l) { \
        for (int j = blockIdx.x; j < 256; j += G) ml_scan_job(p, q, l, j, sm); } PH_END(3 + PH_PER_LAYER * l) \
    PH_BEGIN(4 + PH_PER_LAYER * l) { \
        for (int u = blockIdx.x; u < 512; u += G) ml_out_unit(p, q, l, u, lds); \
        __syncthreads(); } PH_END(4 + PH_PER_LAYER * l) \
    PH_BEGIN(5 + PH_PER_LAYER * l) { \
        pg8::Gemm g{q.ybr, q.wb + (l ? W_BR1 : W_BR0), LDY, 1536, 512}; \
        pg8::Sched<3> S; S.init(NRT, 4, G, (int)blockIdx.x, 512, 0); \
        pg8::EpiBranch E{q.proj, q.tmp, q.act1}; \
        pg8::gemm_phase<pg8::EpiBranch, pg8::Sched<3>, true, true>(lds, g, S, E); } PH_END(5 + PH_PER_LAYER * l) \
    PH_BEGIN(6 + PH_PER_LAYER * l) { \
        pg8::Gemm g{q.act1, q.wb + (l ? W_MIX1 : W_MIX0), DM, DM, DM}; \
        pg8::Sched<1> S; S.init(NRT, 4, G, (int)blockIdx.x, 0, 0); \
        pg8::EpiRes E{l ? q.xf : p->in[0], l ? q.xf + (size_t)MP * DM : q.xs, q.tmp}; \
        pg8::gemm_phase<pg8::EpiRes, pg8::Sched<1>, true, true>(lds, g, S, E); } PH_END(6 + PH_PER_LAYER * l) \
    PH_BEGIN(7 + PH_PER_LAYER * l) { \
        phase_ln(p, q.tmp, p->in[17] + l * DM, p->in[18] + l * DM, q.xf, q.xf + (size_t)MP * DM, q.act1); } PH_END(7 + PH_PER_LAYER * l) \
    PH_BEGIN(8 + PH_PER_LAYER * l) { \
        pg8::Gemm g{q.act1, q.wb + (l ? W_FFI1 : W_FFI0), DM, DM, DM}; \
        pg8::Sched<1> S; S.init(NRT, 2 * DFF / 256, G, (int)blockIdx.x, 0, 0); \
        pg8::EpiSwiglu E{q.hbuf}; \
        pg8::gemm_phase<pg8::EpiSwiglu, pg8::Sched<1>, true, true>(lds, g, S, E); } PH_END(8 + PH_PER_LAYER * l) \
    PH_BEGIN(9 + PH_PER_LAYER * l) { \
        pg8::Gemm g{q.hbuf, q.wb + (l ? W_FFO1 : W_FFO0), DFF, DFF, DFF}; \
        pg8::Sched<1> S; S.init(NRT, 4, G, (int)blockIdx.x, 0, 0); \
        pg8::EpiRes E{q.xf, q.xf + (size_t)MP * DM, q.tmp}; \
        pg8::gemm_phase<pg8::EpiRes, pg8::Sched<1>, true, true>(lds, g, S, E); } PH_END(9 + PH_PER_LAYER * l) \
    PH_BEGIN(10 + PH_PER_LAYER * l) { \
        if (l == DEPTH - 1) phase_ln(p, q.tmp, p->in[21] + l * DM, p->in[22] + l * DM, q.out + O_YP, q.out + O_YS, nullptr); \
        else phase_ln(p, q.tmp, p->in[21] + l * DM, p->in[22] + l * DM, q.xf, q.xf + (size_t)MP * DM, q.act1); } PH_END(10 + PH_PER_LAYER * l)
    LAYER(0)
    LAYER(1)
#undef LAYER
#undef PH_BEGIN
#undef PH_END
}

extern "C" void kernel_launch(void* const* d_in, const int* in_sizes, int n_in, void* d_out, int out_size, void* d_ws, size_t ws_size, hipStream_t stream) {
    static int grid = 0;
    if (grid == 0) {
        if (n_in != 23 || (size_t)out_size != O_END || ws_size < WS_END) {
            fprintf(stderr, "kernel_launch: unexpected shapes: n_in %d out %d (want %zu) ws %zu (need %zu); nothing launched\n", n_in, out_size, (size_t)O_END, ws_size, (size_t)WS_END);
            grid = -1; return;
        }
        int dev = 0, cus = 0;
        if (hipGetDevice(&dev) != hipSuccess || hipDeviceGetAttribute(&cus, hipDeviceAttributeMultiprocessorCount, dev) != hipSuccess) { grid = -1; return; }
        if (hipFuncSetAttribute((const void*)mega, hipFuncAttributeMaxDynamicSharedMemorySize, LDS_BYTES) != hipSuccess) { fprintf(stderr, "kernel_launch: hipFuncSetAttribute failed\n"); grid = -1; return; }
        (void)hipGetLastError();
        grid = cus;
        if (grid != 256) fprintf(stderr, "kernel_launch: note: %d CUs\n", grid);
    }
    if (grid < 0) return;
    (void)hipMemsetAsync((char*)d_ws + WS_CTL, 0, CTL_ZERO_BYTES, stream);
    Args a{};
    for (int i = 0; i < 23; ++i) a.p.in[i] = (const float*)d_in[i];
    a.p.out = (float*)d_out; a.p.ws = (unsigned char*)d_ws; a.p.G = grid; a.p.pad = 0;
#if MK_N_LAUNCHES == 1
    a.ph_lo = 0; a.ph_hi = N_PHASES;
    hipLaunchKernelGGL(mega, dim3(grid), dim3(NTHR), LDS_BYTES, stream, a);
#else
    for (int ph = 0; ph < N_PHASES; ++ph) { a.ph_lo = ph; a.ph_hi = ph + 1; hipLaunchKernelGGL(mega, dim3(grid), dim3(NTHR), LDS_BYTES, stream, a); }
#endif
}
```
